# Optimizing an MI355X kernel written in HIP

```python
import math
import jax, jax.numpy as jnp
from jax import lax
import numpy as np


D_MODEL = 1024
BATCH = 4
SEQ = 8192
DEPTH = 1

ML_WIDTH = D_MODEL
ML_HEADS = 4
ML_HEAD_DIM = ML_WIDTH // ML_HEADS
ML_CHUNK = 128
CONV_WIDTH = 5
DA_WIDTH = D_MODEL
DA_HEADS = 8
DA_V_DIM = DA_WIDTH // DA_HEADS
DA_QK_DIM = DA_V_DIM // 2
Q_BLOCK = 128
ROPE_THETA = 10000.0
NORM_EPS = 1e-6
SEG_SIZES = (ML_WIDTH,) * 5 + (4 * ML_HEADS,) + (DA_WIDTH,) * 4 + (D_MODEL,) * 2
PROJ_WIDTH = sum(SEG_SIZES)

kernel_name = "hybrid_mlstm_diffattn_gated_block"


def _split_points():
    pts, acc = [], 0
    for s in SEG_SIZES[:-1]:
        acc += s
        pts.append(acc)
    return tuple(pts)


def rmsnorm(x, g):
    xf = x.astype(jnp.float32)
    y = xf * lax.rsqrt(jnp.mean(xf * xf, axis=-1, keepdims=True) + NORM_EPS)
    return (y * g.astype(jnp.float32)).astype(x.dtype)


def centred_depthwise_conv(x, w):
    pad = CONV_WIDTH // 2
    return lax.conv_general_dilated(
        x, w[:, None, :].astype(x.dtype), window_strides=(1,), padding=[(pad, pad)],
        dimension_numbers=('NWC', 'WIO', 'NWC'), feature_group_count=x.shape[-1])


def apply_rope(t, positions):
    d = t.shape[-1]
    inv_freq = ROPE_THETA ** (-jnp.arange(0, d, 2, dtype=jnp.float32) / d)
    ang = positions.astype(jnp.float32)[..., None] * inv_freq
    cos = jnp.cos(ang)[:, :, None, None, :]
    sin = jnp.sin(ang)[:, :, None, None, :]
    tf = t.astype(jnp.float32)
    t1, t2 = tf[..., : d // 2], tf[..., d // 2:]
    return jnp.concatenate([t1 * cos - t2 * sin, t2 * cos + t1 * sin], axis=-1)


def mlstm_one_direction(q, k, v, i_pre, log_f):
    B, H, S, d = q.shape
    L = ML_CHUNK
    nc = S // L

    def chunks(t):
        return jnp.moveaxis(t.reshape(t.shape[:2] + (nc, L) + t.shape[3:]), 2, 0)

    lower = jnp.tril(jnp.ones((L, L), dtype=bool))

    def step(carry, inp):
        c_mat, n_vec, m_st = carry
        qc, kc, vc, ic, fc = inp
        b = jnp.cumsum(fc, axis=-1)
        log_d = jnp.where(lower, b[..., :, None] - b[..., None, :] + ic[..., None, :], -jnp.inf)
        log_inter = b + m_st[..., None]
        m_t = jnp.maximum(log_inter, jnp.max(log_d, axis=-1))
        w_intra = jnp.einsum('bhtd,bhsd->bhts', qc, kc) * jnp.exp(log_d - m_t[..., None])
        s_inter = jnp.exp(log_inter - m_t)
        num = (jnp.einsum('bhts,bhsd->bhtd', w_intra, vc)
               + s_inter[..., None] * jnp.einsum('bhvk,bhtk->bhtv', c_mat, qc))
        den = jnp.sum(w_intra, axis=-1) + s_inter * jnp.einsum('bhk,bhtk->bht', n_vec, qc)
        h = num / jnp.maximum(jnp.abs(den), jnp.exp(-m_t))[..., None]
        b_last = b[..., -1]
        log_w = b_last[..., None] - b + ic
        m_new = jnp.maximum(b_last + m_st, jnp.max(log_w, axis=-1))
        w_state = jnp.exp(log_w - m_new[..., None])
        decay = jnp.exp(b_last + m_st - m_new)
        c_new = decay[..., None, None] * c_mat + jnp.einsum('bhsv,bhsk->bhvk', w_state[..., None] * vc, kc)
        n_new = decay[..., None] * n_vec + jnp.einsum('bhs,bhsk->bhk', w_state, kc)
        return (c_new, n_new, m_new), h

    init = (jnp.zeros((B, H, d, d), jnp.float32), jnp.zeros((B, H, d), jnp.float32),
            jnp.zeros((B, H), jnp.float32))
    _, h = lax.scan(step, init, (chunks(q), chunks(k), chunks(v), chunks(i_pre), chunks(log_f)))
    return jnp.moveaxis(h, 0, 2).reshape(B, H, S, d)


def diff_attention(q, k, v, lam):
    B, S, H = q.shape[:3]
    nb = S // Q_BLOCK
    q_blocks = jnp.moveaxis(q.reshape((B, nb, Q_BLOCK) + q.shape[2:]), 1, 0)
    scale = DA_QK_DIM ** -0.5

    def one_block(qb):
        scores = jnp.einsum('bqhjd,bkhjd->bhjqk', qb, k) * scale
        p = jax.nn.softmax(scores, axis=-1)
        p_diff = p[:, :, 0] - lam * p[:, :, 1]
        return jnp.einsum('bhqk,bkhd->bqhd', p_diff, v)

    out = lax.map(one_block, q_blocks)
    return jnp.moveaxis(out, 0, 1).reshape(B, S, H, v.shape[-1])


def setup_inputs(seed: int = 0) -> dict:
    key = jax.random.key(seed)
    ks = jax.random.split(key, 14)
    f32 = jnp.float32
    x = jax.random.normal(ks[0], (BATCH, SEQ, D_MODEL), f32)
    positions = (jnp.arange(SEQ, dtype=jnp.int32)[None, :]
                 + jax.random.randint(ks[1], (BATCH, 1), 0, 1024, dtype=jnp.int32))
    norm_g = 1.0 + 0.02 * jax.random.normal(ks[2], (DEPTH, D_MODEL), f32)
    w_in = jax.random.normal(ks[3], (DEPTH, D_MODEL, PROJ_WIDTH), f32) * D_MODEL ** -0.5
    zeros_h = jnp.zeros((ML_HEADS,), f32)
    f_off = jnp.linspace(3.0, 6.0, ML_HEADS, dtype=f32)
    gate_offsets = jnp.stack([zeros_h, f_off, zeros_h, f_off])
    ml_gate_b = 0.1 * jax.random.normal(ks[4], (DEPTH, 4, ML_HEADS), f32) + gate_offsets[None]
    ml_conv_w = jax.random.normal(ks[5], (DEPTH, CONV_WIDTH, 2 * ML_WIDTH), f32) * CONV_WIDTH ** -0.5
    ml_norm_g = 1.0 + 0.02 * jax.random.normal(ks[6], (DEPTH, ML_HEADS, ML_HEAD_DIM), f32)
    da_lambda = 0.1 * jax.random.normal(ks[7], (DEPTH, 4, DA_QK_DIM), f32)
    da_subln_g = 1.0 + 0.02 * jax.random.normal(ks[8], (DEPTH, DA_V_DIM), f32)
    gate_b = 0.02 * jax.random.normal(ks[9], (DEPTH, 2, D_MODEL), f32)
    w_branch_a = jax.random.normal(ks[10], (DEPTH, ML_WIDTH, D_MODEL), f32) * ML_WIDTH ** -0.5
    w_branch_b = jax.random.normal(ks[11], (DEPTH, DA_WIDTH, D_MODEL), f32) * DA_WIDTH ** -0.5
    w_out = jax.random.normal(ks[12], (DEPTH, D_MODEL, D_MODEL), f32) * D_MODEL ** -0.5
    final_g = 1.0 + 0.02 * jax.random.normal(ks[13], (D_MODEL,), f32)
    return {"x": x, "positions": positions, "norm_g": norm_g, "w_in": w_in,
            "ml_gate_b": ml_gate_b, "ml_conv_w": ml_conv_w, "ml_norm_g": ml_norm_g,
            "da_lambda": da_lambda, "da_subln_g": da_subln_g, "gate_b": gate_b,
            "w_branch_a": w_branch_a, "w_branch_b": w_branch_b, "w_out": w_out,
            "final_g": final_g}


def reference(x, positions, norm_g, w_in, ml_gate_b, ml_conv_w, ml_norm_g, da_lambda,
              da_subln_g, gate_b, w_branch_a, w_branch_b, w_out, final_g):
    B, S, _ = x.shape
    f32 = jnp.float32

    def heads(t):
        return t.reshape(B, S, ML_HEADS, ML_HEAD_DIM).transpose(0, 2, 1, 3).astype(f32)

    def flip(t):
        return jnp.flip(t, axis=2)

    for layer in range(DEPTH):
        h = rmsnorm(x, norm_g[layer])
        proj = jnp.einsum('bsd,de->bse', h, w_in[layer])
        (a_q, a_k, a_v, a_o, a_z, a_g, b_q, b_k, b_v, b_z, g_a, g_b) = jnp.split(
            proj, _split_points(), axis=-1)

        qk = jax.nn.silu(centred_depthwise_conv(jnp.concatenate([a_q, a_k], axis=-1), ml_conv_w[layer]))
        mq = heads(qk[..., :ML_WIDTH])
        mk = heads(qk[..., ML_WIDTH:]) * (ML_HEAD_DIM ** -0.5)
        mv = heads(a_v)
        gates = (a_g.astype(f32).reshape(B, S, 4, ML_HEADS)
                 + ml_gate_b[layer].astype(f32)).transpose(2, 0, 3, 1)
        i_fw, lf_fw = gates[0], jax.nn.log_sigmoid(gates[1])
        i_bw, lf_bw = gates[2], jax.nn.log_sigmoid(gates[3])
        h_fw = mlstm_one_direction(mq, mk, mv, i_fw, lf_fw)
        h_bw = flip(mlstm_one_direction(flip(mq), flip(mk), flip(mv), flip(i_bw), flip(lf_bw)))
        hm = rmsnorm((h_fw + h_bw).transpose(0, 2, 1, 3), ml_norm_g[layer])
        hm = hm.reshape(B, S, ML_WIDTH).astype(x.dtype)
        y_a = hm * jax.nn.sigmoid(a_o) * jax.nn.silu(a_z)

        lambda_init = 0.8 - 0.6 * math.exp(-0.3 * layer)
        lp = da_lambda[layer].astype(f32)
        lam = jnp.exp(jnp.sum(lp[0] * lp[1])) - jnp.exp(jnp.sum(lp[2] * lp[3])) + lambda_init
        dq = apply_rope(b_q.reshape(B, S, DA_HEADS, 2, DA_QK_DIM), positions)
        dk = apply_rope(b_k.reshape(B, S, DA_HEADS, 2, DA_QK_DIM), positions)
        da_v = b_v.reshape(B, S, DA_HEADS, DA_V_DIM).astype(f32)
        att = diff_attention(dq, dk, da_v, lam)
        att = rmsnorm(att, da_subln_g[layer]) * (1.0 - lambda_init)
        y_b = att.reshape(B, S, DA_WIDTH).astype(x.dtype) * jax.nn.silu(b_z)

        gb = gate_b[layer]
        mix = (jax.nn.sigmoid(g_a + gb[0]) * jnp.einsum('bsc,cd->bsd', y_a, w_branch_a[layer])
               + jax.nn.sigmoid(g_b + gb[1]) * jnp.einsum('bsc,cd->bsd', y_b, w_branch_b[layer]))
        x = x + jnp.einsum('bsd,de->bse', mix, w_out[layer])

    return rmsnorm(x, final_g)
```

```cpp
#define MK_NG 2
#include <hip/hip_runtime.h>
#include <hip/hip_cooperative_groups.h>
#include <cstdio>
#include <cstdint>
#include <math.h>
namespace cg = cooperative_groups;

constexpr int SEQ = 8192, DM = 1024, NBATCH = 4, PW = 11280;
constexpr int TOK = NBATCH * SEQ;
#ifndef MK_NG
#define MK_NG 2
#endif
constexpr int NG = MK_NG;
constexpr int NGRP = NBATCH / NG;
constexpr int TG = NG * SEQ;
constexpr int NPROJ = 11264;
constexpr int NCH = 64, CH = 128;
constexpr int NWAVES = 8, NTHR = 512;

constexpr size_t MiB = 1u << 20;
constexpr size_t WS_CTL = 0;
constexpr size_t WS_KMAX = 32768;
constexpr size_t WS_MISC = 1 * MiB;
constexpr size_t WS_WIN = 2 * MiB;
constexpr size_t WS_WA = 24 * MiB, WS_WB = 26 * MiB, WS_WO = 28 * MiB;
constexpr size_t WS_CS = 30 * MiB;
constexpr size_t WS_GATE = 38 * MiB;
constexpr size_t WS_GTOK = 40 * MiB;
constexpr size_t WS_GCH = 44 * MiB;
constexpr size_t WS_NST = 45 * MiB;
constexpr size_t WS_HBF = 48 * MiB;
constexpr size_t GB = (size_t)NG * 16 * MiB;
constexpr size_t WS_G0 = 112 * MiB;
constexpr size_t WS_AQ = WS_G0 + 0 * GB, WS_AK = WS_G0 + 1 * GB, WS_AV = WS_G0 + 2 * GB, WS_OZ = WS_G0 + 3 * GB;
constexpr size_t WS_BV = WS_G0 + 4 * GB, WS_SBZ = WS_G0 + 5 * GB;
constexpr size_t WS_SGA = WS_G0 + 6 * GB, WS_SGB = WS_G0 + 7 * GB;
constexpr size_t WS_YA = WS_G0 + 8 * GB, WS_YB = WS_G0 + 9 * GB;
constexpr size_t WS_MIX = WS_G0 + 10 * GB;
constexpr size_t WS_END = WS_G0 + 11 * GB;
constexpr size_t WS_STF = WS_END;
static_assert(WS_STF + GB <= 512 * MiB, "fw states fit the 512 MiB workspace");
constexpr size_t DO_BQ = 128 * MiB - 2 * GB, DO_BK = 128 * MiB - GB;

#define LAS __attribute__((address_space(3)))
typedef unsigned short bf16_t;
typedef short bf16x8 __attribute__((ext_vector_type(8)));
typedef short s16x4 __attribute__((ext_vector_type(4)));
typedef float f32x4 __attribute__((ext_vector_type(4)));
typedef float f32x2 __attribute__((ext_vector_type(2)));
typedef float f32x16 __attribute__((ext_vector_type(16)));
typedef unsigned u32x4 __attribute__((ext_vector_type(4)));
typedef unsigned u32x2 __attribute__((ext_vector_type(2)));

__device__ __forceinline__ float bf2f(unsigned short v) { return __uint_as_float((unsigned)v << 16); }
__device__ __forceinline__ unsigned f2bf(float f) { unsigned u = __float_as_uint(f); return (u + 0x7fffu + ((u >> 16) & 1u)) >> 16; }
__device__ __forceinline__ unsigned pk2(float lo, float hi) { return f2bf(lo) | (f2bf(hi) << 16); }
__device__ __forceinline__ float fast_exp(float x) { return __builtin_amdgcn_exp2f(x * 1.4426950408889634f); }
__device__ __forceinline__ float fast_sigmoid(float x) { return __builtin_amdgcn_rcpf(1.f + fast_exp(-x)); }
__device__ __forceinline__ float fast_silu(float x) { return x * fast_sigmoid(x); }
#define SHX(v, off) __builtin_bit_cast(float, __builtin_amdgcn_ds_bpermute(((lane) ^ (off)) << 2, __builtin_bit_cast(int, (float)(v))))
#define SHUP(v, off) __builtin_bit_cast(float, __builtin_amdgcn_ds_bpermute(((lane) - (off)) << 2, __builtin_bit_cast(int, (float)(v))))
__device__ __forceinline__ float wave_sum(float v, int lane) {
#pragma unroll
    for (int o = 1; o < 64; o <<= 1) v += SHX(v, o);
    return v;
}

__device__ __forceinline__ int opaque_tid() { int t = threadIdx.x; asm volatile("" : "+v"(t)); return t; }

struct Params {
    const float* x; const int* pos; const float* norm_g; const float* w_in; const float* ml_gate_b; const float* ml_conv_w;
    const float* ml_norm_g; const float* da_lambda; const float* da_subln_g; const float* gate_b; const float* w_a; const float* w_b;
    const float* w_out; const float* final_g;
    float* out; unsigned char* ws;
    int grp; int pad;
};

namespace pg8 {
#define PG8_LAS __attribute__((address_space(3)))
typedef unsigned short bf16_t;
typedef short bf16x8 __attribute__((ext_vector_type(8)));
typedef float f32x4 __attribute__((ext_vector_type(4)));
typedef unsigned u32x4 __attribute__((ext_vector_type(4)));
constexpr int BM = 256, BK = 64, HALF = 128, HTB = HALF * BK * 2  , STAGE_BYTES = 8 * HTB, NXCD = 8, WGM = 8;

__host__ __device__ __forceinline__ int lds_byte(int r, int c) { const int st = (r >> 4) * 2 + (c >> 5), rr = r & 15, cc = c & 31, ob = rr * 64 + cc * 2; return st * 1024 + (ob ^ (((ob >> 9) & 1) << 5)); }
__host__ __device__ __forceinline__ void stage_rc(int b, int& R, int& C) { const int st = b / 1024, sb = b % 1024, swz = sb ^ (((sb >> 9) & 1) << 5); R = (st >> 1) * 16 + swz / 64; C = (st & 1) * 32 + (swz % 64) / 2; }
__host__ __device__ __forceinline__ int perm32(int rho) { const int n = rho >> 4, i = rho & 15; return 8 * (i >> 2) + 4 * n + (i & 3); }

struct Unit { int pm, pn; };
struct Gemm { const bf16_t* A; const bf16_t* Bt; int M, N, K; };

struct StaticOrder {
    int nM, nN, nwg, G, c;
    __host__ __device__ void init(int M, int N, int G_, int c_) { nM = M / BM; nN = N / BM; nwg = nM * nN; G = G_; c = c_; }
    __host__ __device__ bool next(int i, Unit& u) const {
        const long L = (long)i * G + c; if (L >= nwg) return false;
        int wgid = (int)L; { const int q = nwg / NXCD, r = nwg % NXCD, xcd = wgid % NXCD, off = wgid / NXCD; wgid = (xcd < r ? xcd * (q + 1) : r * (q + 1) + (xcd - r) * q) + off; }
        const int nig = WGM * nN, gid = wgid / nig, fm = gid * WGM, gsz = (nM - fm) < WGM ? (nM - fm) : WGM;
        u.pm = fm + ((wgid % nig) % gsz); u.pn = (wgid % nig) / gsz; return true;
    }
    __device__ __forceinline__ void a_ready(const Unit&) const {}
    __device__ __forceinline__ void done(const Unit&) const {}
};

typedef __bf16 bf16x2_t __attribute__((ext_vector_type(2)));
typedef float f32x2_t __attribute__((ext_vector_type(2)));
__device__ __forceinline__ unsigned cvt_pk_bf16(float lo, float hi) { f32x2_t v = {lo, hi}; bf16x2_t b = __builtin_convertvector(v, bf16x2_t); return __builtin_bit_cast(unsigned, b); }

__host__ __device__ __forceinline__ int proj_orig_col(int n) {
    const int pn = n >> 8, c = n & 255;
    if (pn < 12) return pn * 256 + c;
    if (pn < 20) { const int i = pn - 12; return (c < 128 ? 3072 : 4096) + i * 128 + (c & 127); }
    if (pn < 28) { const int base = pn < 24 ? 5136 : 6160, q = (pn - 20) & 3, cc = c & 127; return base + (4 * q + (cc >> 5)) * 64 + (c >= 128 ? 32 : 0) + (cc & 31); }
    return 7184 + (pn - 28) * 256 + c;
}
__device__ __forceinline__ void store8(bf16_t* p, const f32x4 v0, const f32x4 v1) {
    u32x4 w; w.x = cvt_pk_bf16(v0[0], v0[1]); w.y = cvt_pk_bf16(v0[2], v0[3]); w.z = cvt_pk_bf16(v1[0], v1[1]); w.w = cvt_pk_bf16(v1[2], v1[3]);
    __builtin_nontemporal_store(w, (u32x4*)p);
}
__device__ __forceinline__ f32x4 sig4(f32x4 v) { f32x4 r; r[0] = fast_sigmoid(v[0]); r[1] = fast_sigmoid(v[1]); r[2] = fast_sigmoid(v[2]); r[3] = fast_sigmoid(v[3]); return r; }
__device__ __forceinline__ f32x4 silu4(f32x4 v) { f32x4 r; r[0] = fast_silu(v[0]); r[1] = fast_silu(v[1]); r[2] = fast_silu(v[2]); r[3] = fast_silu(v[3]); return r; }

constexpr float QSCALE = 0.125f * 1.4426950408889634f;
struct EpiProj {
    static constexpr bool PERM = true, AFTER_DRAIN = false;
    unsigned char* ws; unsigned char* dout; const float* gate_b; int grp;
    __device__ __forceinline__ void operator()(const f32x4 (&acc)[2][2][4][2], const Unit& u, int wr, int wc, int fr, int fq) const {
        const int pn = u.pn;
        const int r0 = u.pm * 256 + wr * 64 + fr;
        const int bl = r0 >> 13, s0 = r0 & (SEQ - 1);
        const int c8 = wc * 32 + 8 * fq;
        if (pn < 12) {
            const int kind = pn >> 2, h = pn & 3;
            bf16_t* base = (bf16_t*)(ws + (kind == 0 ? WS_AQ : kind == 1 ? WS_AK : WS_AV)) + ((size_t)(bl * 4 + h) * SEQ + s0) * 256 + c8;
#pragma unroll
            for (int ai = 0; ai < 2; ++ai)
#pragma unroll
                for (int m = 0; m < 4; ++m)
#pragma unroll
                    for (int bj = 0; bj < 2; ++bj) store8(base + (size_t)(ai * 128 + m * 16) * 256 + bj * 128, acc[ai][bj][m][0], acc[ai][bj][m][1]);
        } else if (pn < 20) {
            const int i = pn - 12, h = i >> 1;
            bf16_t* base = (bf16_t*)(ws + WS_OZ) + ((size_t)(bl * 4 + h) * SEQ + s0) * 256 + (i & 1) * 128 + c8;
#pragma unroll
            for (int ai = 0; ai < 2; ++ai)
#pragma unroll
                for (int m = 0; m < 4; ++m)
                    store8(base + (size_t)(ai * 128 + m * 16) * 256, sig4(acc[ai][0][m][0]) * silu4(acc[ai][1][m][0]), sig4(acc[ai][0][m][1]) * silu4(acc[ai][1][m][1]));
        } else if (pn < 28) {
            const bool isq = pn < 24; const int q = (pn - 20) & 3, head = 2 * q + (wc >> 1), map = wc & 1;
            bf16_t* base = (bf16_t*)(dout + (isq ? DO_BQ : DO_BK)) + ((size_t)(bl * 8 + head) * SEQ + s0) * 128 + map * 64 + 8 * fq;
            float kn2 = 0.f; const int lane = fq * 16 + fr;
            const f32x4* cs = (const f32x4*)(ws + WS_CS) + ((size_t)(grp * TG + r0) * 32 + 8 * fq) / 2;
#pragma unroll
            for (int ai = 0; ai < 2; ++ai)
#pragma unroll
                for (int m = 0; m < 4; ++m) {
                    const int ro = ai * 128 + m * 16;
                    const f32x4* c4 = cs + (size_t)ro * 16;
                    f32x4 o1[2], o2[2];
#pragma unroll
                    for (int n = 0; n < 2; ++n) {
                        const f32x4 ca = c4[2 * n], cb = c4[2 * n + 1];
                        const f32x4 t1 = acc[ai][0][m][n], t2 = acc[ai][1][m][n];
                        o1[n][0] = t1[0] * ca[0] - t2[0] * ca[1]; o2[n][0] = t2[0] * ca[0] + t1[0] * ca[1];
                        o1[n][1] = t1[1] * ca[2] - t2[1] * ca[3]; o2[n][1] = t2[1] * ca[2] + t1[1] * ca[3];
                        o1[n][2] = t1[2] * cb[0] - t2[2] * cb[1]; o2[n][2] = t2[2] * cb[0] + t1[2] * cb[1];
                        o1[n][3] = t1[3] * cb[2] - t2[3] * cb[3]; o2[n][3] = t2[3] * cb[2] + t1[3] * cb[3];
                    }
                    if (isq) { o1[0] = o1[0] * QSCALE; o1[1] = o1[1] * QSCALE; o2[0] = o2[0] * QSCALE; o2[1] = o2[1] * QSCALE; }
                    else { float n2 = 0.f;
#pragma unroll
                        for (int n = 0; n < 2; ++n)
#pragma unroll
                            for (int j = 0; j < 4; ++j) n2 += o1[n][j] * o1[n][j] + o2[n][j] * o2[n][j];
                        n2 += SHX(n2, 16); n2 += SHX(n2, 32);
                        kn2 = fmaxf(kn2, n2); }
                    store8(base + (size_t)ro * 128, o1[0], o1[1]); store8(base + (size_t)ro * 128 + 32, o2[0], o2[1]);
                }
            if (!isq) {
                kn2 = fmaxf(kn2, SHX(kn2, 1)); kn2 = fmaxf(kn2, SHX(kn2, 2)); kn2 = fmaxf(kn2, SHX(kn2, 4)); kn2 = fmaxf(kn2, SHX(kn2, 8));
                if (fr == 0 && fq == 0) atomicMax((unsigned*)(ws + WS_KMAX) + ((size_t)(grp * NG + bl) * 8 + head) * 2 + map, __float_as_uint(kn2));
            }
        } else if (pn < 36) {
            const bool isz = pn >= 32; const int q = (pn - 28) & 3;
#pragma unroll
            for (int bj = 0; bj < 2; ++bj) {
                const int head = 2 * q + bj;
                bf16_t* base = (bf16_t*)(ws + (isz ? WS_SBZ : WS_BV)) + ((size_t)(bl * 8 + head) * SEQ + s0) * 128 + c8;
#pragma unroll
                for (int ai = 0; ai < 2; ++ai)
#pragma unroll
                    for (int m = 0; m < 4; ++m) {
                        f32x4 v0 = acc[ai][bj][m][0], v1 = acc[ai][bj][m][1];
                        if (isz) { v0 = silu4(v0); v1 = silu4(v1); }
                        store8(base + (size_t)(ai * 128 + m * 16) * 128, v0, v1);
                    }
            }
        } else {
            const bool isa = pn < 40; const int cb = ((pn - 36) & 3) * 256;
#pragma unroll
            for (int bj = 0; bj < 2; ++bj) {
                bf16_t* base = (bf16_t*)(ws + (isa ? WS_SGA : WS_SGB)) + (size_t)r0 * 1024 + cb + bj * 128 + c8;
                const float* bp = gate_b + (isa ? 0 : 1024) + cb + bj * 128 + c8;
                const f32x4 b0 = *(const f32x4*)bp, b1 = *(const f32x4*)(bp + 4);
#pragma unroll
                for (int ai = 0; ai < 2; ++ai)
#pragma unroll
                    for (int m = 0; m < 4; ++m)
                        store8(base + (size_t)(ai * 128 + m * 16) * 1024, sig4(acc[ai][bj][m][0] + b0), sig4(acc[ai][bj][m][1] + b1));
            }
        }
    }
};

__device__ __forceinline__ f32x4 bf4lo(const u32x4 w) { return (f32x4){__uint_as_float(w.x << 16), __uint_as_float(w.x & 0xffff0000u), __uint_as_float(w.y << 16), __uint_as_float(w.y & 0xffff0000u)}; }
__device__ __forceinline__ f32x4 bf4hi(const u32x4 w) { return (f32x4){__uint_as_float(w.z << 16), __uint_as_float(w.z & 0xffff0000u), __uint_as_float(w.w << 16), __uint_as_float(w.w & 0xffff0000u)}; }
template <bool ADD> struct EpiMix {
    static constexpr bool PERM = true, AFTER_DRAIN = false;
    const bf16_t* gate; bf16_t* mix;
    __device__ __forceinline__ void operator()(const f32x4 (&acc)[2][2][4][2], const Unit& u, int wr, int wc, int fr, int fq) const {
        const int r0 = u.pm * 256 + wr * 64 + fr, c0 = u.pn * 256 + wc * 32 + 8 * fq;
#pragma unroll
        for (int ai = 0; ai < 2; ++ai)
#pragma unroll
            for (int m = 0; m < 4; ++m)
#pragma unroll
                for (int bj = 0; bj < 2; ++bj) {
                    const size_t off = (size_t)(r0 + ai * 128 + m * 16) * 1024 + c0 + bj * 128;
                    const u32x4 g = *(const u32x4*)(gate + off);
                    f32x4 v0 = acc[ai][bj][m][0] * bf4lo(g), v1 = acc[ai][bj][m][1] * bf4hi(g);
                    if (ADD) { const u32x4 o = *(const u32x4*)(mix + off); v0 = v0 + bf4lo(o); v1 = v1 + bf4hi(o); }
                    store8(mix + off, v0, v1);
                }
    }
};
struct EpiResid {
    static constexpr bool PERM = false, AFTER_DRAIN = false;
    const float* resid; float* out;
    __device__ __forceinline__ void operator()(const f32x4 (&acc)[2][2][4][2], const Unit& u, int wr, int wc, int fr, int fq) const {
        const int r0 = u.pm * 256 + wr * 64 + fr, c0 = u.pn * 256 + wc * 32 + 4 * fq;
#pragma unroll
        for (int ai = 0; ai < 2; ++ai)
#pragma unroll
            for (int m = 0; m < 4; ++m)
#pragma unroll
                for (int bj = 0; bj < 2; ++bj)
#pragma unroll
                    for (int n = 0; n < 2; ++n) {
                        const size_t off = (size_t)(r0 + ai * 128 + m * 16) * 1024 + c0 + bj * 128 + n * 16;
                        *(f32x4*)(out + off) = *(const f32x4*)(resid + off) + acc[ai][bj][m][n];
                    }
    }
};
template <class Epi, class Sched, bool ALIGN_EPI = false, bool SP2 = false>
__device__ __forceinline__ void gemm_phase(PG8_LAS unsigned char* lds, const Gemm g, const Sched& S, const Epi& E) {
    const int tid = opaque_tid(), wid = __builtin_amdgcn_readfirstlane(tid >> 6), lane = tid & 63, wr = wid >> 2, wc = wid & 3, fr = lane & 15, fq = lane >> 4;
    const int K = g.K, nt = K / BK;
    unsigned voffA[2], voffB[2];
#pragma unroll
    for (int i = 0; i < 2; ++i) { int R, C; stage_rc(tid * 16 + i * 8192, R, C); const int Rb = Epi::PERM ? ((R & ~31) + perm32(R & 31)) : R;
        voffA[i] = (unsigned)(R * K + C) * 2u; voffB[i] = (unsigned)(Rb * K + C) * 2u; }
    const size_t kstep = (size_t)(BK * 2);
    const size_t hstep = (size_t)HALF * K * 2;
    const size_t tstep = 2 * hstep;
    const unsigned ldsw = (unsigned)wid * 1024u;
    const int aoff = lds_byte(wr * 64 + fr, fq * 8), boff = lds_byte(wc * 32 + fr, fq * 8);
#define PG8_SA(b, h) (((b) * 2 + (h)) * HTB)
#define PG8_SB(b, h) ((4 + (b) * 2 + (h)) * HTB)
#define PG8_STAGE(bufoff, gbase, voff) do { _Pragma("unroll") for (int _i = 0; _i < 2; ++_i) \
        __builtin_amdgcn_global_load_lds((const unsigned*)((const char*)(gbase) + (voff)[_i]), (PG8_LAS unsigned*)(lds + (bufoff) + ldsw + _i * 8192), 16, 0, 0); } while (0)
#define PG8_LDA(dst, b, h) do { _Pragma("unroll") for (int m = 0; m < 4; ++m) _Pragma("unroll") for (int k = 0; k < 2; ++k) dst[m][k] = *(const PG8_LAS bf16x8*)(lds + PG8_SA(b, h) + aoff + m * 2048 + k * 1024); } while (0)
#define PG8_LDB(dst, b, h) do { _Pragma("unroll") for (int n = 0; n < 2; ++n) _Pragma("unroll") for (int k = 0; k < 2; ++k) dst[n][k] = *(const PG8_LAS bf16x8*)(lds + PG8_SB(b, h) + boff + n * 2048 + k * 1024); } while (0)
#define PG8_MMA(ai, bj, At, Bt) do { __builtin_amdgcn_s_setprio(1); _Pragma("unroll") for (int m = 0; m < 4; ++m) _Pragma("unroll") for (int n = 0; n < 2; ++n) _Pragma("unroll") for (int k = 0; k < 2; ++k) \
        acc[ai][bj][m][n] = __builtin_amdgcn_mfma_f32_16x16x32_bf16(Bt[n][k], At[m][k], acc[ai][bj][m][n], 0, 0, 0); __builtin_amdgcn_s_setprio(0); } while (0)
#define PG8_WAIT_V(n) asm volatile("s_waitcnt vmcnt(" #n ")" ::: "memory")
#define PG8_WAIT_L(n) asm volatile("s_waitcnt lgkmcnt(" #n ")" ::: "memory")
#define PG8_BAR __builtin_amdgcn_s_barrier()
#define PG8_SCHED __builtin_amdgcn_sched_barrier(0)
    Unit cur, nxt; int ui = 0;
    if (!S.next(0, cur)) return;
    f32x4 acc[2][2][4][2];
#pragma unroll
    for (int a = 0; a < 2; ++a)
#pragma unroll
        for (int b = 0; b < 2; ++b)
#pragma unroll
            for (int m = 0; m < 4; ++m)
#pragma unroll
                for (int n = 0; n < 2; ++n) acc[a][b][m][n] = (f32x4){0.f, 0.f, 0.f, 0.f};
    bf16x8 At[4][2], B0[2][2], B1[2][2];
    const char* cA = (const char*)g.A + (size_t)cur.pm * tstep; const char* cB = (const char*)g.Bt + (size_t)cur.pn * tstep;
    S.a_ready(cur);
    if constexpr (SP2) {
        PG8_STAGE(PG8_SB(0, 0), cB, voffB); PG8_STAGE(PG8_SB(0, 1), cB + hstep, voffB); PG8_STAGE(PG8_SA(0, 0), cA, voffA); PG8_STAGE(PG8_SA(0, 1), cA + hstep, voffA);
        if (wr == 1) PG8_BAR;
        PG8_WAIT_V(2); PG8_BAR;
        PG8_STAGE(PG8_SB(1, 0), cB + kstep, voffB); PG8_STAGE(PG8_SA(1, 0), cA + kstep, voffA); PG8_STAGE(PG8_SB(1, 1), cB + hstep + kstep, voffB);
        PG8_WAIT_V(6); PG8_BAR;
    } else {
        PG8_STAGE(PG8_SB(0, 0), cB, voffB); PG8_STAGE(PG8_SA(0, 0), cA, voffA); PG8_STAGE(PG8_SB(0, 1), cB + hstep, voffB); PG8_STAGE(PG8_SA(0, 1), cA + hstep, voffA);
        if (wr == 1) PG8_BAR;
        PG8_WAIT_V(4); PG8_BAR;
        PG8_STAGE(PG8_SB(1, 0), cB + kstep, voffB); PG8_STAGE(PG8_SA(1, 0), cA + kstep, voffA); PG8_STAGE(PG8_SB(1, 1), cB + hstep + kstep, voffB);
        PG8_WAIT_V(6); PG8_BAR;
    }
    for (;;) {
        const bool has_next = S.next(ui + 1, nxt);
        const char* nA = has_next ? (const char*)g.A + (size_t)nxt.pm * tstep : cA; const char* nB = has_next ? (const char*)g.Bt + (size_t)nxt.pn * tstep : cB;
        for (int t = 0; t < nt; t += 2) {
            const bool last = (t == nt - 2);
            const char* a1 = cA + (size_t)(t + 1) * kstep;
            const char* a2 = last ? nA : cA + (size_t)(t + 2) * kstep; const char* b2 = last ? nB : cB + (size_t)(t + 2) * kstep;
            const char* a3 = a2 + kstep; const char* b3 = b2 + kstep;
            if (last && has_next) S.a_ready(nxt);
            if constexpr (SP2) {
            PG8_LDB(B0, 0, 0); PG8_LDB(B1, 0, 1); PG8_SCHED; PG8_LDA(At, 0, 0); PG8_STAGE(PG8_SA(1, 1), a1 + hstep, voffA);
            PG8_WAIT_V(8); PG8_WAIT_L(0); PG8_BAR; PG8_MMA(0, 0, At, B0); PG8_MMA(0, 1, At, B1); PG8_BAR; PG8_SCHED;
            PG8_LDA(At, 0, 1); PG8_STAGE(PG8_SB(0, 0), b2, voffB); PG8_STAGE(PG8_SB(0, 1), b2 + hstep, voffB); PG8_STAGE(PG8_SA(0, 0), a2, voffA);
            PG8_WAIT_V(8); PG8_WAIT_L(0); PG8_BAR; PG8_MMA(1, 0, At, B0); PG8_MMA(1, 1, At, B1); PG8_BAR; PG8_SCHED;
            PG8_LDB(B0, 1, 0); PG8_LDB(B1, 1, 1); PG8_SCHED; PG8_LDA(At, 1, 0); PG8_STAGE(PG8_SA(0, 1), a2 + hstep, voffA);
            PG8_WAIT_V(8); PG8_WAIT_L(0); PG8_BAR; PG8_MMA(0, 0, At, B0); PG8_MMA(0, 1, At, B1); PG8_BAR; PG8_SCHED;
            PG8_LDA(At, 1, 1); PG8_STAGE(PG8_SB(1, 0), b3, voffB); PG8_STAGE(PG8_SB(1, 1), b3 + hstep, voffB); PG8_STAGE(PG8_SA(1, 0), a3, voffA);
            PG8_WAIT_V(8); PG8_WAIT_L(0); PG8_BAR; PG8_MMA(1, 0, At, B0); PG8_MMA(1, 1, At, B1); PG8_BAR; PG8_SCHED;
            } else {
            PG8_LDB(B0, 0, 0); PG8_SCHED; PG8_LDA(At, 0, 0); PG8_STAGE(PG8_SA(1, 1), a1 + hstep, voffA);
            PG8_WAIT_L(8); PG8_BAR; PG8_WAIT_L(0); PG8_MMA(0, 0, At, B0); PG8_BAR; PG8_SCHED;
            PG8_LDB(B1, 0, 1); PG8_STAGE(PG8_SB(0, 0), b2, voffB);
            PG8_BAR; PG8_WAIT_L(0); PG8_MMA(0, 1, At, B1); PG8_BAR;
            PG8_LDA(At, 0, 1); PG8_STAGE(PG8_SA(0, 0), a2, voffA);
            PG8_BAR; PG8_WAIT_L(0); PG8_MMA(1, 0, At, B0); PG8_BAR; PG8_SCHED;
            PG8_STAGE(PG8_SB(0, 1), b2 + hstep, voffB);
            PG8_WAIT_V(6); PG8_BAR; PG8_MMA(1, 1, At, B1); PG8_BAR;
            PG8_LDB(B0, 1, 0); PG8_SCHED; PG8_LDA(At, 1, 0); PG8_STAGE(PG8_SA(0, 1), a2 + hstep, voffA);
            PG8_WAIT_L(8); PG8_BAR; PG8_WAIT_L(0); PG8_MMA(0, 0, At, B0); PG8_BAR; PG8_SCHED;
            PG8_LDB(B1, 1, 1); PG8_STAGE(PG8_SB(1, 0), b3, voffB);
            PG8_BAR; PG8_WAIT_L(0); PG8_MMA(0, 1, At, B1); PG8_BAR;
            PG8_LDA(At, 1, 1); PG8_STAGE(PG8_SA(1, 0), a3, voffA);
            PG8_BAR; PG8_WAIT_L(0); PG8_MMA(1, 0, At, B0); PG8_BAR; PG8_SCHED;
            PG8_STAGE(PG8_SB(1, 1), b3 + hstep, voffB);
            PG8_WAIT_V(6); PG8_BAR; PG8_MMA(1, 1, At, B1); PG8_BAR;
            }
        }
        if constexpr (ALIGN_EPI) { if (wr == 0) PG8_BAR; }
        if constexpr (!Epi::AFTER_DRAIN) { E(acc, cur, wr, wc, fr, fq); S.done(cur); }
        if (!has_next) break;
#pragma unroll
        for (int a = 0; a < 2; ++a)
#pragma unroll
            for (int b = 0; b < 2; ++b)
#pragma unroll
                for (int m = 0; m < 4; ++m)
#pragma unroll
                    for (int n = 0; n < 2; ++n) acc[a][b][m][n] = (f32x4){0.f, 0.f, 0.f, 0.f};
        cur = nxt; cA = nA; cB = nB; ++ui;
        if constexpr (ALIGN_EPI) { if (wr == 1) PG8_BAR; }
    }
    PG8_WAIT_V(0);
    if constexpr (!ALIGN_EPI) { if (wr == 0) PG8_BAR; }
    PG8_BAR;
    if constexpr (Epi::AFTER_DRAIN) { E.fused(acc, cur, wr, wc, fr, fq, lds, wid, lane); S.done(cur); }
#undef PG8_SA
#undef PG8_SB
#undef PG8_STAGE
#undef PG8_LDA
#undef PG8_LDB
#undef PG8_MMA
#undef PG8_WAIT_V
#undef PG8_WAIT_L
#undef PG8_BAR
#undef PG8_SCHED
}
}

constexpr int LDS_BYTES = 163840;

__device__ __forceinline__ int vcu_of(int bx, int G) { return (G % 8 == 0) ? (bx % 8) * (G / 8) + bx / 8 : bx; }

__device__ __forceinline__ void p0_transpose_item(const float* W, int ldw, int col0, int k0, bf16_t* WTrow0, int K, LAS float* scr, int lane) {
#pragma unroll 8
    for (int i = 0; i < 32; ++i) { const int kk = 2 * i + (lane >> 5); scr[kk * 33 + (lane & 31)] = W[(size_t)(k0 + kk) * ldw + col0 + (lane & 31)]; }
    asm volatile("s_waitcnt lgkmcnt(0)" ::: "memory");
    const int c = lane & 7;
#pragma unroll
    for (int j = 0; j < 4; ++j) { const int n = (lane >> 3) + 8 * j; const LAS float* s = scr + (8 * c) * 33 + n;
        u32x4 o; o.x = pk2(s[0 * 33], s[1 * 33]); o.y = pk2(s[2 * 33], s[3 * 33]); o.z = pk2(s[4 * 33], s[5 * 33]); o.w = pk2(s[6 * 33], s[7 * 33]);
        *(u32x4*)(WTrow0 + (size_t)n * K + k0 + 8 * c) = o; }
    asm volatile("s_waitcnt lgkmcnt(0)" ::: "memory");
}

__device__ __forceinline__ void phase_prologue(const Params& p, LAS unsigned char* lds) {
    const int tid = opaque_tid(), lane = tid & 63, wave = __builtin_amdgcn_readfirstlane(tid >> 6);
    const int G = gridDim.x, gw = blockIdx.x * NWAVES + wave, NGW = G * NWAVES;
    unsigned char* ws = p.ws;
    {
        LAS float* scr = (LAS float*)(lds + wave * 16384);
        constexpr int I_IN = 16 * (NPROJ / 32), I_SQ = 16 * 32;
        for (int it = gw; it < I_IN + 3 * I_SQ; it += NGW) {
            if (it < I_IN) { const int kb = it / (NPROJ / 32), nb = it % (NPROJ / 32);
                p0_transpose_item(p.w_in, PW, pg8::proj_orig_col(nb * 32), kb * 64, (bf16_t*)(ws + WS_WIN) + (size_t)(nb * 32) * DM, DM, scr, lane); }
            else { const int r = it - I_IN, wsel = r / I_SQ, rr = r % I_SQ, kb = rr / 32, nb = rr % 32;
                const float* W = wsel == 0 ? p.w_a : wsel == 1 ? p.w_b : p.w_out;
                bf16_t* WT = (bf16_t*)(ws + (wsel == 0 ? WS_WA : wsel == 1 ? WS_WB : WS_WO));
                p0_transpose_item(W, DM, nb * 32, kb * 64, WT + (size_t)(nb * 32) * DM, DM, scr, lane); }
        }
    }
    for (int e = blockIdx.x * NTHR + tid; e < TOK * 32; e += G * NTHR) {
        const int t = e >> 5, i = e & 31;
        const float inv = (float)exp(-(double)(2 * i) * (9.210340371976184 / 64.0));
        const float ang = (float)p.pos[t] * inv;
        double rev = (double)ang * 0.15915494309189535; rev -= rint(rev);
        f32x2 cs; cs.x = __builtin_amdgcn_cosf((float)rev); cs.y = __builtin_amdgcn_sinf((float)rev);
        ((f32x2*)(ws + WS_CS))[e] = cs;
    }
    if (blockIdx.x == 0 && tid == 0) {
        float a = 0.f, b = 0.f;
        for (int i = 0; i < 64; ++i) { a += p.da_lambda[i] * p.da_lambda[64 + i]; b += p.da_lambda[128 + i] * p.da_lambda[192 + i]; }
        ((float*)(ws + WS_MISC))[0] = expf(a) - expf(b) + 0.2f;
    }
    __syncthreads();
    LAS float* wg = (LAS float*)lds;
    for (int k = tid; k < DM; k += NTHR) {
        const float* src = p.w_in + (size_t)k * PW + 5120;
#pragma unroll
        for (int q = 0; q < 4; ++q) { const f32x4 v = *(const f32x4*)(src + 4 * q);
            wg[(4 * q + 0) * DM + k] = v[0]; wg[(4 * q + 1) * DM + k] = v[1]; wg[(4 * q + 2) * DM + k] = v[2]; wg[(4 * q + 3) * DM + k] = v[3]; }
    }
    __syncthreads();
    f32x4 vn[4];
    if (gw < TOK) { const f32x4* xr = (const f32x4*)(p.x + (size_t)gw * DM) + lane;
#pragma unroll
        for (int j = 0; j < 4; ++j) vn[j] = xr[64 * j]; }
    for (int m = gw; m < TOK; m += NGW) {
        f32x4 v[4]; float s = 0.f;
#pragma unroll
        for (int j = 0; j < 4; ++j) { v[j] = vn[j]; s += (v[j][0] * v[j][0] + v[j][1] * v[j][1]) + (v[j][2] * v[j][2] + v[j][3] * v[j][3]); }
        if (m + NGW < TOK) { const f32x4* xr = (const f32x4*)(p.x + (size_t)(m + NGW) * DM) + lane;
#pragma unroll
            for (int j = 0; j < 4; ++j) vn[j] = xr[64 * j]; }
        const float rstd = rsqrtf(wave_sum(s, lane) * (1.f / DM) + 1e-6f);
#pragma unroll
        for (int j = 0; j < 4; ++j) { const f32x4 g = *((const f32x4*)p.norm_g + lane + 64 * j); v[j] = v[j] * rstd * g; }
        unsigned long long* o8 = (unsigned long long*)((bf16_t*)(ws + WS_HBF) + (size_t)m * DM) + lane;
#pragma unroll
        for (int j = 0; j < 4; ++j) o8[64 * j] = (unsigned long long)pk2(v[j][0], v[j][1]) | ((unsigned long long)pk2(v[j][2], v[j][3]) << 32);
        float mine = 0.f;
#pragma unroll
        for (int gi = 0; gi < 16; ++gi) {
            float a = 0.f;
            asm volatile("" ::: "memory");
#pragma unroll
            for (int j = 0; j < 4; ++j) { const f32x4 w = *(const LAS f32x4*)(wg + gi * DM + 4 * lane + 256 * j); a += (v[j][0] * w[0] + v[j][1] * w[1]) + (v[j][2] * w[2] + v[j][3] * w[3]); }
            a = wave_sum(a, lane);
            if (lane == gi) mine = a;
        }
        if (lane < 16) ((float*)(ws + WS_GATE))[(size_t)m * 16 + lane] = mine;
    }
}

__device__ __forceinline__ void phase_inproj(const Params& p, LAS unsigned char* lds, int grp) {
    pg8::Gemm g{(const bf16_t*)(p.ws + WS_HBF) + (size_t)grp * TG * DM, (const bf16_t*)(p.ws + WS_WIN), TG, NPROJ, DM};
    pg8::StaticOrder S; S.init(TG, NPROJ, gridDim.x, (int)blockIdx.x);
    pg8::EpiProj E{p.ws, (unsigned char*)p.out, p.gate_b, grp};
    pg8::gemm_phase<pg8::EpiProj, pg8::StaticOrder, true, true>(lds, g, S, E);
}

namespace att {
constexpr int KVBLK = 64;
constexpr float SCALE = 0.125f, THR = 8.f;
constexpr int SHM_V = KVBLK * 128 * 2, SHM_K = KVBLK * 128 * 2, SHM_ATTN = 2 * SHM_V + 2 * SHM_K + NWAVES * 64 * 4;
#define KSWZ(row, colB) ((row) * 256 + ((colB) ^ (((row) & 7) << 4)))
#define SBAR() __builtin_amdgcn_sched_barrier(0)
__device__ __forceinline__ int crow(int r, int hi) { return (r & 3) + 8 * (r >> 2) + 4 * hi; }
__device__ __forceinline__ unsigned cvtpk(float lo, float hi) { return pg8::cvt_pk_bf16(lo, hi); }

__device__ __forceinline__ void expHalf(f32x16& p) {
#pragma unroll
    for (int r = 0; r < 16; ++r) p[r] = __builtin_amdgcn_exp2f(p[r]);
}
__device__ __forceinline__ void packP(const f32x16& p0, const f32x16& p1, bf16x8& pa0, bf16x8& pa1, bf16x8& pa2, bf16x8& pa3) {
#define PK4(P, BASE, OUT) do { unsigned a0 = cvtpk(P[BASE + 0], P[BASE + 1]), a1 = cvtpk(P[BASE + 2], P[BASE + 3]);   \
    unsigned b0 = cvtpk(P[BASE + 4], P[BASE + 5]), b1 = cvtpk(P[BASE + 6], P[BASE + 7]);                              \
    auto r0 = __builtin_amdgcn_permlane32_swap(a0, b0, false, false); auto r1 = __builtin_amdgcn_permlane32_swap(a1, b1, false, false); \
    u32x4 w = {r0[0], r1[0], r0[1], r1[1]}; OUT = *reinterpret_cast<bf16x8*>(&w); } while (0)
    PK4(p0, 0, pa0); PK4(p0, 8, pa1); PK4(p1, 0, pa2); PK4(p1, 8, pa3);
#undef PK4
}
__device__ __forceinline__ void qkt(f32x16& p0, f32x16& p1, const char* Ks, const bf16x8* qr, float negm, int g, int r32, int hi) {
#pragma unroll
    for (int r = 0; r < 16; ++r) { p0[r] = negm; p1[r] = negm; }
#pragma unroll
    for (int d0 = 0; d0 < 4; ++d0) { const int cb = ((g * 4 + d0) * 16 + hi * 8) * 2;
        const bf16x8 b0 = *reinterpret_cast<const bf16x8*>(Ks + KSWZ(r32, cb));
        const bf16x8 b1 = *reinterpret_cast<const bf16x8*>(Ks + KSWZ(32 + r32, cb));
        p0 = __builtin_amdgcn_mfma_f32_32x32x16_bf16(b0, qr[d0], p0, 0, 0, 0);
        p1 = __builtin_amdgcn_mfma_f32_32x32x16_bf16(b1, qr[d0], p1, 0, 0, 0); }
}
__device__ __forceinline__ int v_st(int k, int c) { const int kk = (k & ~0xC) | ((k & 4) << 1) | ((k & 8) >> 1); return ((kk >> 3) * 4 + (c >> 5)) * 512 + ((kk & 7) * 32 + (c & 31)) * 2; }
__device__ __forceinline__ int v_rd_base(int lane) { return ((lane & 3) << 3) | (((lane >> 2) & 3) << 6) | (((lane >> 4) & 1) << 5) | (((lane >> 5) & 1) << 8); }
constexpr int v_rd_off(int d0, int ks, int half) { return d0 * 512 + ks * 4096 + half * 2048; }
template <int OFF> __device__ __forceinline__ s16x4 tr_read(int vb) {
    s16x4 r; asm volatile("ds_read_b64_tr_b16 %0, %1 offset:%2" : "=&v"(r) : "v"(vb), "i"(OFF) : "memory"); return r;
}
#define PV_LOAD8(R, D0) const s16x4 R##0 = tr_read<v_rd_off(D0, 0, 0)>(vb), R##1 = tr_read<v_rd_off(D0, 0, 1)>(vb), R##2 = tr_read<v_rd_off(D0, 1, 0)>(vb), R##3 = tr_read<v_rd_off(D0, 1, 1)>(vb), \
    R##4 = tr_read<v_rd_off(D0, 2, 0)>(vb), R##5 = tr_read<v_rd_off(D0, 2, 1)>(vb), R##6 = tr_read<v_rd_off(D0, 3, 0)>(vb), R##7 = tr_read<v_rd_off(D0, 3, 1)>(vb)
#define PV_PK(L, H) (bf16x8){L[0], L[1], L[2], L[3], H[0], H[1], H[2], H[3]}
#define PV_MMA4(OD, R) do { OD = __builtin_amdgcn_mfma_f32_32x32x16_bf16(pa0, PV_PK(R##0, R##1), OD, 0, 0, 0); OD = __builtin_amdgcn_mfma_f32_32x32x16_bf16(pa1, PV_PK(R##2, R##3), OD, 0, 0, 0); \
    OD = __builtin_amdgcn_mfma_f32_32x32x16_bf16(pa2, PV_PK(R##4, R##5), OD, 0, 0, 0); OD = __builtin_amdgcn_mfma_f32_32x32x16_bf16(pa3, PV_PK(R##6, R##7), OD, 0, 0, 0); } while (0)
__device__ __forceinline__ void pv_d0(f32x16* o, f32x16& lacc, int vb, bf16x8 pa0, bf16x8 pa1, bf16x8 pa2, bf16x8 pa3) {
    const bf16x8 ones = {0x3F80, 0x3F80, 0x3F80, 0x3F80, 0x3F80, 0x3F80, 0x3F80, 0x3F80};
    PV_LOAD8(a, 0); SBAR();
    lacc = __builtin_amdgcn_mfma_f32_32x32x16_bf16(pa0, ones, lacc, 0, 0, 0); lacc = __builtin_amdgcn_mfma_f32_32x32x16_bf16(pa1, ones, lacc, 0, 0, 0);
    lacc = __builtin_amdgcn_mfma_f32_32x32x16_bf16(pa2, ones, lacc, 0, 0, 0); lacc = __builtin_amdgcn_mfma_f32_32x32x16_bf16(pa3, ones, lacc, 0, 0, 0);
    SBAR(); PV_LOAD8(b, 1); asm volatile("s_waitcnt lgkmcnt(8)" ::: "memory"); SBAR(); PV_MMA4(o[0], a);
    SBAR(); PV_LOAD8(c, 2); asm volatile("s_waitcnt lgkmcnt(8)" ::: "memory"); SBAR(); PV_MMA4(o[1], b);
    SBAR(); PV_LOAD8(d, 3); asm volatile("s_waitcnt lgkmcnt(8)" ::: "memory"); SBAR(); PV_MMA4(o[2], c);
    asm volatile("s_waitcnt lgkmcnt(0)" ::: "memory"); SBAR(); PV_MMA4(o[3], d);
}
#undef PV_LOAD8
#undef PV_PK
#undef PV_MMA4

#define TR_LOAD8(R, D0) do { R##0 = tr_read<v_rd_off(D0, 0, 0)>(vb); R##1 = tr_read<v_rd_off(D0, 0, 1)>(vb); R##2 = tr_read<v_rd_off(D0, 1, 0)>(vb); R##3 = tr_read<v_rd_off(D0, 1, 1)>(vb); \
    R##4 = tr_read<v_rd_off(D0, 2, 0)>(vb); R##5 = tr_read<v_rd_off(D0, 2, 1)>(vb); R##6 = tr_read<v_rd_off(D0, 3, 0)>(vb); R##7 = tr_read<v_rd_off(D0, 3, 1)>(vb); } while (0)
#define TR_PK(L, H) (bf16x8){L[0], L[1], L[2], L[3], H[0], H[1], H[2], H[3]}
#define TR_MMA4(OD, R) do { OD = __builtin_amdgcn_mfma_f32_32x32x16_bf16(po0, TR_PK(R##0, R##1), OD, 0, 0, 0); OD = __builtin_amdgcn_mfma_f32_32x32x16_bf16(po1, TR_PK(R##2, R##3), OD, 0, 0, 0); \
    OD = __builtin_amdgcn_mfma_f32_32x32x16_bf16(po2, TR_PK(R##4, R##5), OD, 0, 0, 0); OD = __builtin_amdgcn_mfma_f32_32x32x16_bf16(po3, TR_PK(R##6, R##7), OD, 0, 0, 0); } while (0)
#define EXP8(P, B) do { _Pragma("unroll") for (int _r = 0; _r < 8; ++_r) P[(B) + _r] = __builtin_amdgcn_exp2f(P[(B) + _r]); } while (0)
#define SUM8(P, B) do { ls[0] += P[(B) + 0] + P[(B) + 4]; ls[1] += P[(B) + 1] + P[(B) + 5]; ls[2] += P[(B) + 2] + P[(B) + 6]; ls[3] += P[(B) + 3] + P[(B) + 7]; } while (0)
#define CVT4(P, B, W) do { W[0] = cvtpk(P[(B) + 0], P[(B) + 1]); W[1] = cvtpk(P[(B) + 2], P[(B) + 3]); W[2] = cvtpk(P[(B) + 4], P[(B) + 5]); W[3] = cvtpk(P[(B) + 6], P[(B) + 7]); } while (0)
#define SWAP4(W, OUT) do { auto _r0 = __builtin_amdgcn_permlane32_swap(W[0], W[2], false, false); auto _r1 = __builtin_amdgcn_permlane32_swap(W[1], W[3], false, false); \
    u32x4 _w = {_r0[0], _r1[0], _r0[1], _r1[1]}; OUT = *reinterpret_cast<bf16x8*>(&_w); } while (0)
#define WAITL0() asm volatile("s_waitcnt lgkmcnt(0)" ::: "memory")
#define TRL(R, D0, I0, I1, I2, I3) do { R##I0 = tr_read<v_rd_off(D0, I0 >> 1, I0 & 1)>(vb); R##I1 = tr_read<v_rd_off(D0, I1 >> 1, I1 & 1)>(vb); R##I2 = tr_read<v_rd_off(D0, I2 >> 1, I2 & 1)>(vb); R##I3 = tr_read<v_rd_off(D0, I3 >> 1, I3 & 1)>(vb); } while (0)
#define MMO(OD, PO, L, H) OD = __builtin_amdgcn_mfma_f32_32x32x16_bf16(PO, TR_PK(L, H), OD, 0, 0, 0)
#define EX(P, I) P[I] = __builtin_amdgcn_exp2f(P[I])
#define AD(P, I) do { ls[(I) & 3] += P[I]; asm volatile("" : "+v"(ls[(I) & 3])); } while (0)
#define CV(W, J, P, I) W[J] = cvtpk(P[I], P[(I) + 1])
#define KLD(DST, D0) do { const int _cb = ((g * 4 + (D0)) * 16 + hi * 8) * 2; DST[0] = *reinterpret_cast<const bf16x8*>(Ks + KSWZ(r32, _cb)); DST[1] = *reinterpret_cast<const bf16x8*>(Ks + KSWZ(32 + r32, _cb)); } while (0)
template <bool DO_QT, bool DO_QK, bool DO_SM, bool DO_PV, bool DK, bool DV>
__device__ __forceinline__ void step3(bf16x8 (&kc)[2][2], const bf16_t* kg, const bf16_t* vg, char* kd, char* vd, unsigned koff, unsigned voff, f32x16* o, float (&ls)[4], int vb, const char* Ks, const bf16x8* qr, float negm, int g, int r32, int hi, f32x16& c0, f32x16& c1, f32x16& n0, f32x16& n1,
                                      bf16x8 po0, bf16x8 po1, bf16x8 po2, bf16x8 po3, bf16x8& pn0, bf16x8& pn1, bf16x8& pn2, bf16x8& pn3) {
    s16x4 a0, a1, a2, a3, a4, a5, a6, a7, b0, b1, b2, b3, b4, b5, b6, b7;
    unsigned w0[4], w1[4], w2[4], w3[4];
    bf16x8 kf[2][2];
    if constexpr (DO_PV) TRL(a, 0, 0, 1, 2, 3);
    if constexpr (DO_QT) c0 = __builtin_amdgcn_mfma_f32_32x32x16_bf16(kc[0][0], qr[2], c0, 0, 0, 0);
    SBAR();
    if constexpr (DO_PV) TRL(a, 0, 4, 5, 6, 7);
    if constexpr (DO_QT) c1 = __builtin_amdgcn_mfma_f32_32x32x16_bf16(kc[0][1], qr[2], c1, 0, 0, 0);
    SBAR();
    if constexpr (DK) __builtin_amdgcn_global_load_lds((const unsigned*)(kg + koff), (LAS unsigned*)kd, 16, 0, 0);
    if constexpr (DO_QT) c0 = __builtin_amdgcn_mfma_f32_32x32x16_bf16(kc[1][0], qr[3], c0, 0, 0, 0);
    SBAR();
    if constexpr (DO_QT) c1 = __builtin_amdgcn_mfma_f32_32x32x16_bf16(kc[1][1], qr[3], c1, 0, 0, 0);
    if constexpr (DO_PV) WAITL0();
    SBAR();
    if constexpr (DO_PV) { TRL(b, 1, 0, 1, 2, 3); MMO(o[0], po0, a0, a1); } SBAR();
    if constexpr (DO_PV) { TRL(b, 1, 4, 5, 6, 7); MMO(o[0], po1, a2, a3); } SBAR();
    if constexpr (DK) __builtin_amdgcn_global_load_lds((const unsigned*)(kg + 4 * 128 + (koff ^ 32u)), (LAS unsigned*)(kd + 1024), 16, 0, 0);
    if constexpr (DO_PV) { MMO(o[0], po2, a4, a5); } SBAR();
    if constexpr (DO_PV) { MMO(o[0], po3, a6, a7); WAITL0(); } SBAR();
    if constexpr (DO_PV) { TRL(a, 2, 0, 1, 2, 3); MMO(o[1], po0, b0, b1); }
    if constexpr (DO_SM) { EX(c0, 0); EX(c0, 1); EX(c0, 2); } SBAR();
    if constexpr (DO_PV) { TRL(a, 2, 4, 5, 6, 7); MMO(o[1], po1, b2, b3); }
    if constexpr (DO_SM) { EX(c0, 3); EX(c0, 4); EX(c0, 5); AD(c0, 0); AD(c0, 1); AD(c0, 2); } SBAR();
    if constexpr (DV) __builtin_amdgcn_global_load_lds((const unsigned*)(vg + voff), (LAS unsigned*)vd, 16, 0, 0);
    if constexpr (DO_PV) { MMO(o[1], po2, b4, b5); }
    if constexpr (DO_SM) { EX(c0, 6); EX(c0, 7); EX(c0, 8); AD(c0, 3); AD(c0, 4); AD(c0, 5); } SBAR();
    if constexpr (DO_PV) { MMO(o[1], po3, b6, b7); }
    if constexpr (DO_SM) { EX(c0, 9); EX(c0, 10); EX(c0, 11); AD(c0, 6); AD(c0, 7); AD(c0, 8); }
    if constexpr (DO_PV) WAITL0();
    SBAR();
    if constexpr (DO_PV) { TRL(b, 3, 0, 1, 2, 3); MMO(o[2], po0, a0, a1); }
    if constexpr (DO_SM) { EX(c0, 12); EX(c0, 13); EX(c0, 14); AD(c0, 9); AD(c0, 10); AD(c0, 11); } SBAR();
    if constexpr (DO_PV) { TRL(b, 3, 4, 5, 6, 7); MMO(o[2], po1, a2, a3); }
    if constexpr (DO_SM) { EX(c0, 15); EX(c1, 0); EX(c1, 1); AD(c0, 12); AD(c0, 13); AD(c0, 14); } SBAR();
    if constexpr (DV) __builtin_amdgcn_global_load_lds((const unsigned*)(vg + 64 + voff), (LAS unsigned*)(vd + 1024), 16, 0, 0);
    if constexpr (DO_PV) { MMO(o[2], po2, a4, a5); }
    if constexpr (DO_SM) { EX(c1, 2); EX(c1, 3); EX(c1, 4); AD(c0, 15); AD(c1, 0); AD(c1, 1); } SBAR();
    if constexpr (DO_PV) { MMO(o[2], po3, a6, a7); }
    if constexpr (DO_SM) { EX(c1, 5); EX(c1, 6); EX(c1, 7); AD(c1, 2); AD(c1, 3); AD(c1, 4); }
    if constexpr (DO_PV) WAITL0();
    SBAR();
    if constexpr (DO_QK) KLD(kf[0], 0);
    if constexpr (DO_PV) { MMO(o[3], po0, b0, b1); }
    if constexpr (DO_SM) { EX(c1, 8); EX(c1, 9); EX(c1, 10); AD(c1, 5); AD(c1, 6); AD(c1, 7); CV(w0, 0, c0, 0); CV(w0, 1, c0, 2); } SBAR();
    if constexpr (DO_QK) KLD(kf[1], 1);
    if constexpr (DO_PV) { MMO(o[3], po1, b2, b3); }
    if constexpr (DO_SM) { EX(c1, 11); EX(c1, 12); EX(c1, 13); AD(c1, 8); AD(c1, 9); AD(c1, 10); CV(w0, 2, c0, 4); CV(w0, 3, c0, 6); } SBAR();
    if constexpr (DO_PV) { MMO(o[3], po2, b4, b5); }
    if constexpr (DO_SM) { EX(c1, 14); EX(c1, 15); AD(c1, 11); AD(c1, 12); AD(c1, 13); CV(w1, 0, c0, 8); CV(w1, 1, c0, 10); } SBAR();
    if constexpr (DO_PV) { MMO(o[3], po3, b6, b7); }
    if constexpr (DO_SM) { AD(c1, 14); AD(c1, 15); CV(w1, 2, c0, 12); CV(w1, 3, c0, 14); } SBAR();
    if constexpr (DO_QK) {
#pragma unroll
        for (int r = 0; r < 16; ++r) { n0[r] = negm; n1[r] = negm; }
        KLD(kc[0], 2); n0 = __builtin_amdgcn_mfma_f32_32x32x16_bf16(kf[0][0], qr[0], n0, 0, 0, 0); }
    if constexpr (DO_SM) { CV(w2, 0, c1, 0); CV(w2, 1, c1, 2); } SBAR();
    if constexpr (DO_QK) { KLD(kc[1], 3); n1 = __builtin_amdgcn_mfma_f32_32x32x16_bf16(kf[0][1], qr[0], n1, 0, 0, 0); }
    if constexpr (DO_SM) { CV(w2, 2, c1, 4); CV(w2, 3, c1, 6); } SBAR();
    if constexpr (DO_QK) n0 = __builtin_amdgcn_mfma_f32_32x32x16_bf16(kf[1][0], qr[1], n0, 0, 0, 0);
    if constexpr (DO_SM) { CV(w3, 0, c1, 8); CV(w3, 1, c1, 10); } SBAR();
    if constexpr (DO_QK) n1 = __builtin_amdgcn_mfma_f32_32x32x16_bf16(kf[1][1], qr[1], n1, 0, 0, 0);
    if constexpr (DO_SM) { CV(w3, 2, c1, 12); CV(w3, 3, c1, 14); }
    if constexpr (DO_SM) { u32x4 t0 = {w0[0], w0[1], w0[2], w0[3]}, t1 = {w1[0], w1[1], w1[2], w1[3]}, t2 = {w2[0], w2[1], w2[2], w2[3]}, t3 = {w3[0], w3[1], w3[2], w3[3]};
        pn0 = *reinterpret_cast<bf16x8*>(&t0); pn1 = *reinterpret_cast<bf16x8*>(&t1); pn2 = *reinterpret_cast<bf16x8*>(&t2); pn3 = *reinterpret_cast<bf16x8*>(&t3); }
    SBAR();
}

__device__ __forceinline__ void attn_unit(const Params& p, int grp, int bh, int q0, char* lds) {
    const bf16_t* __restrict__ Qh; const bf16_t* __restrict__ Kh; const bf16_t* __restrict__ Vh; const float* __restrict__ k2;
    { const size_t ho = (size_t)bh * SEQ * 128;
      Qh = (const bf16_t*)((const unsigned char*)p.out + DO_BQ) + ho; Kh = (const bf16_t*)((const unsigned char*)p.out + DO_BK) + ho; Vh = (const bf16_t*)(p.ws + WS_BV) + ho;
      k2 = (const float*)(p.ws + WS_KMAX) + ((size_t)grp * NG * 8 + bh) * 2; }
    constexpr int LDK = 128;
    const int tid = opaque_tid(), wid = tid >> 6, lane = tid & 63, r32 = lane & 31, hi = lane >> 5, g = wid >> 2, wq = wid & 3;
    char* V_lds = lds; char* K_lds = lds + 2 * SHM_V;
    f32x16 o[4] = {}; float ls[4] = {0.f, 0.f, 0.f, 0.f}; bf16x8 qr[4];
    const bf16_t* Qw = Qh + (size_t)(q0 + wq * 32 + r32) * 128 + g * 64 + hi * 8;
#pragma unroll
    for (int d0 = 0; d0 < 4; ++d0) qr[d0] = *reinterpret_cast<const bf16x8*>(Qw + d0 * 16);
    float negm;
    { float ss = 0.f;
#pragma unroll
      for (int d0 = 0; d0 < 4; ++d0)
#pragma unroll
          for (int e = 0; e < 8; ++e) { const float q = bf2f((unsigned short)qr[d0][e]); ss = fmaf(q, q, ss); }
      auto rr = __builtin_amdgcn_permlane32_swap(__float_as_uint(ss), __float_as_uint(ss), false, false);
      ss = __uint_as_float(rr[0]) + __uint_as_float(rr[1]);
      negm = -sqrtf(ss * k2[g]); }
    const int vb0 = (int)(uintptr_t)V_lds + v_rd_base(lane);
    const int widu = __builtin_amdgcn_readfirstlane(wid);
    unsigned koff, voff;
    { const int a = widu * 2048 + lane * 16;
      const int row = a >> 8, colB = (a & 255) ^ ((row & 7) << 4); koff = (unsigned)(row * LDK + (colB >> 1));
      const int sub = a >> 9, kk = (sub >> 2) * 8 + ((a & 511) >> 6), k = kk, c = (sub & 3) * 32 + ((a & 63) >> 1); voff = (unsigned)(k * LDK + c); }
#define DMA_K(slot, k0) do { __builtin_amdgcn_global_load_lds((const unsigned*)(Kh + (size_t)(k0) * LDK + koff), (LAS unsigned*)(K_lds + (slot) * SHM_K + widu * 2048), 16, 0, 0); \
    __builtin_amdgcn_global_load_lds((const unsigned*)(Kh + (size_t)(k0) * LDK + 4 * LDK + (koff ^ 32u)), (LAS unsigned*)(K_lds + (slot) * SHM_K + widu * 2048 + 1024), 16, 0, 0); } while (0)
#define DMA_V(slot, k0) do { __builtin_amdgcn_global_load_lds((const unsigned*)(Vh + (size_t)(k0) * LDK + voff), (LAS unsigned*)(V_lds + (slot) * SHM_V + widu * 2048), 16, 0, 0); \
    __builtin_amdgcn_global_load_lds((const unsigned*)(Vh + (size_t)(k0) * LDK + 64 + voff), (LAS unsigned*)(V_lds + (slot) * SHM_V + widu * 2048 + 1024), 16, 0, 0); } while (0)
#define SWAIT() asm volatile("s_waitcnt vmcnt(0)" ::: "memory")
    f32x16 sA0, sA1, sB0, sB1; bf16x8 pX0, pX1, pX2, pX3, pY0, pY1, pY2, pY3; constexpr int NT = SEQ / KVBLK;
#define STEP(QT, QK, SM, PV, DK, DV, KT, VT, VS, KS, C0, C1, N0, N1, PO, PN) step3<QT, QK, SM, PV, DK, DV>(kc, Kh + (size_t)(KT) * (KVBLK * LDK), Vh + (size_t)(VT) * (KVBLK * LDK), \
        K_lds + ((KT) & 1) * SHM_K + widu * 2048, V_lds + ((VT) & 1) * SHM_V + widu * 2048, koff, voff, o, ls, vb0 + (VS) * SHM_V, K_lds + (KS) * SHM_K, qr, negm, g, r32, hi, C0, C1, N0, N1, PO##0, PO##1, PO##2, PO##3, PN##0, PN##1, PN##2, PN##3)
    bf16x8 kc[2][2];
    DMA_K(0, 0); DMA_K(1, KVBLK); DMA_V(0, 0); SWAIT(); __syncthreads();
    STEP(false, true, false, false, false, false, 0, 0, 0, 0, sB0, sB1, sA0, sA1, pY, pX);
    __syncthreads();
    DMA_K(0, 2 * KVBLK);
    STEP(true, true, true, false, false, false, 0, 0, 0, 1, sA0, sA1, sB0, sB1, pY, pX);
    SWAIT(); __syncthreads();
    for (int n = 1; n + 1 < NT; n += 2) {
        STEP(true, true, true, true, true, true, n + 2, n, 0, 0, sB0, sB1, sA0, sA1, pX, pY);
        SWAIT(); __syncthreads();
        const int kt = n + 3 < NT ? n + 3 : NT - 2;
        STEP(true, true, true, true, true, true, kt, n + 1, 1, 1, sA0, sA1, sB0, sB1, pY, pX);
        SWAIT(); __syncthreads();
    }
    STEP(true, false, true, true, false, true, 0, NT - 1, 0, 0, sB0, sB1, sA0, sA1, pX, pY);
    SWAIT(); __syncthreads();
    STEP(false, false, false, true, false, false, 0, 0, 1, 0, sA0, sA1, sB0, sB1, pY, pX);
    int bh2 = bh; asm volatile("" : "+s"(bh2));
    const bf16_t* __restrict__ Zh = (const bf16_t*)(p.ws + WS_SBZ) + (size_t)bh2 * SEQ * 128;
    bf16_t* __restrict__ Yrow0 = (bf16_t*)(p.ws + WS_YB) + (size_t)(bh2 >> 3) * SEQ * 1024 + (bh2 & 7) * 128;
    const float* __restrict__ subg = p.da_subln_g; const float* __restrict__ lamp = (const float*)(p.ws + WS_MISC);
    float rli[16];
    { float lt = (ls[0] + ls[1]) + (ls[2] + ls[3]);
      auto rr = __builtin_amdgcn_permlane32_swap(__float_as_uint(lt), __float_as_uint(lt), false, false);
      lt = __builtin_amdgcn_rcpf(__uint_as_float(rr[0]) + __uint_as_float(rr[1]));
#pragma unroll
      for (int r = 0; r < 16; ++r) rli[r] = __uint_as_float((unsigned)__builtin_amdgcn_ds_bpermute(crow(r, hi) * 4, (int)__float_as_uint(lt))); }
    __syncthreads();
    float* X = (float*)lds;
    if (g == 1) {
        const float lam = *lamp;
#pragma unroll
        for (int d0 = 0; d0 < 4; ++d0)
#pragma unroll
            for (int r = 0; r < 16; ++r) X[((wq * 4 + d0) * 16 + r) * 64 + lane] = o[d0][r] * rli[r] * lam;
    }
    __syncthreads();
    if (g == 0) {
        float ss[16];
#pragma unroll
        for (int r = 0; r < 16; ++r) { float a = 0.f;
#pragma unroll
            for (int d0 = 0; d0 < 4; ++d0) { const float v = o[d0][r] * rli[r] - X[((wq * 4 + d0) * 16 + r) * 64 + lane]; o[d0][r] = v; a += v * v; }
            ss[r] = a; }
#pragma unroll
        for (int r = 0; r < 16; ++r) {
#pragma unroll
            for (int off = 1; off < 32; off <<= 1) ss[r] += SHX(ss[r], off);
        }
        float sg[4];
#pragma unroll
        for (int d0 = 0; d0 < 4; ++d0) sg[d0] = subg[32 * d0 + r32] * 0.8f;
        float* Yt = (float*)(lds + 69632);
#pragma unroll
        for (int r = 0; r < 16; ++r) {
            const float rs = rsqrtf(ss[r] * (1.f / 128.f) + 1e-6f);
            const int lrow = wq * 32 + crow(r, hi);
#pragma unroll
            for (int d0 = 0; d0 < 4; ++d0) Yt[lrow * 128 + 32 * d0 + r32] = o[d0][r] * rs * sg[d0];
        }
    }
    __syncthreads();
    {
        const float* Yt = (const float*)(lds + 69632);
        const int tid3 = opaque_tid();
#pragma unroll
        for (int i = 0; i < 4; ++i) {
            const int e = tid3 + 512 * i, lrow = e >> 4, c8 = (e & 15) * 8;
            const size_t qrow = (size_t)(q0 + lrow);
            const bf16x8 z = *(const bf16x8*)(Zh + qrow * 128 + c8);
            const f32x4 y0 = *(const f32x4*)(Yt + lrow * 128 + c8), y1 = *(const f32x4*)(Yt + lrow * 128 + c8 + 4);
            u32x4 pk;
            pk.x = pg8::cvt_pk_bf16(y0[0] * bf2f((unsigned short)z[0]), y0[1] * bf2f((unsigned short)z[1])); pk.y = pg8::cvt_pk_bf16(y0[2] * bf2f((unsigned short)z[2]), y0[3] * bf2f((unsigned short)z[3]));
            pk.z = pg8::cvt_pk_bf16(y1[0] * bf2f((unsigned short)z[4]), y1[1] * bf2f((unsigned short)z[5])); pk.w = pg8::cvt_pk_bf16(y1[2] * bf2f((unsigned short)z[6]), y1[3] * bf2f((unsigned short)z[7]));
            *(u32x4*)(Yrow0 + qrow * 1024 + c8) = pk;
        }
    }
    __syncthreads();
#undef DMA_K
#undef DMA_V
#undef SWAIT
#undef STEP
}
}

__device__ __forceinline__ void phase_attention(const Params& p, char* lds, int grp) {
    const int G = gridDim.x, vcu = vcu_of(blockIdx.x, G);
    for (int it = vcu; it < NG * 8 * 64; it += G) att::attn_unit(p, grp, it >> 6, (it & 63) * 128, lds);
}

namespace ml {
constexpr int GT_A = 0, GT_B = 1, GT_MR = 2;
constexpr int GC_BLAST = 0, GC_AMAX = 1, GC_MST = 2, GC_DECAY = 3, GC_GAIN = 4;
__device__ __forceinline__ float* gtok(unsigned char* ws, int gch, int row) { return (float*)(ws + WS_GTOK) + ((size_t)gch * 3 + row) * SEQ; }
__device__ __forceinline__ float* gch_(unsigned char* ws, int gch, int row) { return (float*)(ws + WS_GCH) + ((size_t)gch * 8 + row) * NCH; }
constexpr float ST_SC = 16.f, ST_ISC = 0.0625f, ST_MAX = 448.f;
__device__ __forceinline__ unsigned char* state_ptr(const Params& p, int grp, int ch, int c) {
    const int bl = ch >> 3, dir = (ch >> 2) & 1, h = ch & 3, li = bl * 4 + h;
    unsigned char* base = dir ? p.ws + WS_HBF + (size_t)grp * TG * DM * 2 : p.ws + WS_STF;
    return base + ((size_t)li * NCH + c) * 65536;
}
__device__ __forceinline__ float st_clamp(float x) { return fminf(fmaxf(x * ST_SC, -ST_MAX), ST_MAX); }
__device__ __forceinline__ unsigned st_pack4(float a, float b, float c, float d) {
    int w = __builtin_amdgcn_cvt_pk_fp8_f32(st_clamp(a), st_clamp(b), 0, false);
    w = __builtin_amdgcn_cvt_pk_fp8_f32(st_clamp(c), st_clamp(d), w, true);
    return (unsigned)w;
}
__device__ __forceinline__ float* nstate_ptr(const Params& p, int gch, int c) { return (float*)(p.ws + WS_NST) + ((size_t)gch * NCH + c) * 256; }

__device__ __forceinline__ void phase_gateprep(const Params& p, int grp) {
    const int tid = opaque_tid(), lane = tid & 63, wave = tid >> 6;
    for (int it = blockIdx.x * NWAVES + wave; it < NG * 8 * NCH; it += gridDim.x * NWAVES) {
        const int ch = it >> 6, c = it & 63;
        const int bl = ch >> 3, dir = (ch >> 2) & 1, h = ch & 3, gch = grp * NG * 8 + ch, b = grp * NG + bl;
        const float* gates = (const float*)(p.ws + WS_GATE) + (size_t)b * SEQ * 16;
        const int ci = (2 * dir) * 4 + h, cf = (2 * dir + 1) * 4 + h;
        const float bi = p.ml_gate_b[ci], bf = p.ml_gate_b[cf];
        float* A = gtok(p.ws, gch, GT_A); float* B = gtok(p.ws, gch, GT_B); float* MR = gtok(p.ws, gch, GT_MR);
        float iv[2], lf[2];
#pragma unroll
        for (int q = 0; q < 2; ++q) {
            const int pp = c * CH + 2 * lane + q, s = dir ? SEQ - 1 - pp : pp;
            iv[q] = gates[(size_t)s * 16 + ci] + bi;
            const float f = gates[(size_t)s * 16 + cf] + bf;
            lf[q] = fminf(f, 0.f) - log1pf(expf(-fabsf(f)));
        }
        float tot = lf[0] + lf[1], inc = tot;
#pragma unroll
        for (int off = 1; off < 64; off <<= 1) { const float v = SHUP(inc, off); if (lane >= off) inc += v; }
        const float ex = inc - tot;
        const float b0 = ex + lf[0], b1 = ex + lf[0] + lf[1];
        const float a0 = iv[0] - b0, a1 = iv[1] - b1;
        float mx = fmaxf(a0, a1), minc = mx;
#pragma unroll
        for (int off = 1; off < 64; off <<= 1) { const float v = SHUP(minc, off); if (lane >= off) minc = fmaxf(minc, v); }
        float mex = SHUP(minc, 1); if (lane == 0) mex = -INFINITY;
        const float pm0 = fmaxf(mex, a0), pm1 = fmaxf(pm0, a1);
        const int p0 = c * CH + 2 * lane;
        A[p0] = a0; A[p0 + 1] = a1; B[p0] = b0; B[p0 + 1] = b1; MR[p0] = b0 + pm0; MR[p0 + 1] = b1 + pm1;
        if (lane == 63) { gch_(p.ws, gch, GC_BLAST)[c] = b1; gch_(p.ws, gch, GC_AMAX)[c] = pm1; }
    }
}
__device__ __forceinline__ void phase_gatescan(const Params& p, LAS unsigned char* lds, int grp) {
    const int tid = opaque_tid();
    LAS float* sb = (LAS float*)lds;
    for (int ch = blockIdx.x; ch < NG * 8; ch += gridDim.x) {
        const int gch = grp * NG * 8 + ch;
        if (tid < NCH) { sb[tid] = gch_(p.ws, gch, GC_BLAST)[tid]; sb[NCH + tid] = gch_(p.ws, gch, GC_AMAX)[tid]; }
        __syncthreads();
        if (tid == 0) {
            float* MS = gch_(p.ws, gch, GC_MST); float* DE = gch_(p.ws, gch, GC_DECAY); float* GA = gch_(p.ws, gch, GC_GAIN);
            float mprev = 0.f;
            for (int c = 0; c < NCH; ++c) {
                const float bl_ = sb[c], am = sb[NCH + c], mloc = bl_ + am, mnew = fmaxf(bl_ + mprev, mloc);
                MS[c] = mprev; DE[c] = expf(bl_ + mprev - mnew); GA[c] = expf(mloc - mnew);
                mprev = mnew;
            }
        }
        __syncthreads();
    }
}

constexpr int TS = 528;
constexpr int TILE_B = 128 * TS;
constexpr int PS = 272;
constexpr int CS_ = 144, CBUF = 256 * CS_;
constexpr int R0 = 0, R1 = TILE_B, R1_B = 2 * CBUF;
constexpr int SC0 = R1 + R1_B;
static_assert(SC0 + 3328 * 4 <= LDS_BYTES, "mLSTM LDS map");

__device__ __forceinline__ void stage_conv(const bf16_t* __restrict__ src, int s0, const float* __restrict__ cw  ,
                                           float scale, LAS unsigned char* dst) {
    const int tid = opaque_tid(), cg = tid & 31, rg = tid >> 5;
    float w[5][8];
#pragma unroll
    for (int j = 0; j < 5; ++j) { const f32x4 w0 = *(const f32x4*)(cw + j * 2048 + cg * 8), w1 = *(const f32x4*)(cw + j * 2048 + cg * 8 + 4);
        w[j][0] = w0[0]; w[j][1] = w0[1]; w[j][2] = w0[2]; w[j][3] = w0[3]; w[j][4] = w1[0]; w[j][5] = w1[1]; w[j][6] = w1[2]; w[j][7] = w1[3]; }
    const bf16x8 zero8 = {0, 0, 0, 0, 0, 0, 0, 0};
    const int sb = s0 + rg * 8 - 2;
    bf16x8 in[12];
#pragma unroll
    for (int i = 0; i < 12; ++i) { const int s = sb + i; in[i] = (s >= 0 && s < SEQ) ? *(const bf16x8*)(src + (size_t)s * 256 + cg * 8) : zero8; }
#pragma unroll
    for (int r = 0; r < 8; ++r) {
        float o[8];
#pragma unroll
        for (int e = 0; e < 8; ++e) {
            float a = w[0][e] * bf2f((unsigned short)in[r][e]);
            a = fmaf(w[1][e], bf2f((unsigned short)in[r + 1][e]), a); a = fmaf(w[2][e], bf2f((unsigned short)in[r + 2][e]), a);
            a = fmaf(w[3][e], bf2f((unsigned short)in[r + 3][e]), a); a = fmaf(w[4][e], bf2f((unsigned short)in[r + 4][e]), a);
            o[e] = fast_silu(a) * scale; }
        u32x4 pk; pk.x = pg8::cvt_pk_bf16(o[0], o[1]); pk.y = pg8::cvt_pk_bf16(o[2], o[3]); pk.z = pg8::cvt_pk_bf16(o[4], o[5]); pk.w = pg8::cvt_pk_bf16(o[6], o[7]);
        *(LAS u32x4*)(dst + (rg * 8 + r) * TS + cg * 16) = pk;
    }
}
__device__ __forceinline__ void stage_rows(const bf16_t* __restrict__ src, int s0, const LAS float* wrow, LAS unsigned char* dst) {
    const int tid = opaque_tid(), cg = tid & 31, rg = tid >> 5;
#pragma unroll
    for (int r = 0; r < 8; ++r) {
        const int row = rg * 8 + r;
        bf16x8 v = *(const bf16x8*)(src + (size_t)(s0 + row) * 256 + cg * 8);
        if (wrow) { const float w = wrow[row]; u32x4 pk;
            pk.x = pg8::cvt_pk_bf16(bf2f((unsigned short)v[0]) * w, bf2f((unsigned short)v[1]) * w); pk.y = pg8::cvt_pk_bf16(bf2f((unsigned short)v[2]) * w, bf2f((unsigned short)v[3]) * w);
            pk.z = pg8::cvt_pk_bf16(bf2f((unsigned short)v[4]) * w, bf2f((unsigned short)v[5]) * w); pk.w = pg8::cvt_pk_bf16(bf2f((unsigned short)v[6]) * w, bf2f((unsigned short)v[7]) * w);
            *(LAS u32x4*)(dst + row * TS + cg * 16) = pk; }
        else *(LAS bf16x8*)(dst + row * TS + cg * 16) = v;
    }
}
__device__ __forceinline__ bf16x8 frag_tr(const LAS unsigned char* tile, int stride, int k0, int n0, int lane) {
    const int g = lane >> 4, i = lane & 15, q = i >> 2, pp = i & 3;
    const LAS unsigned char* a = tile + (k0 + 8 * g + q) * stride + (n0 + 4 * pp) * 2;
    typedef short v4i16_t __attribute__((ext_vector_type(4)));
    const s16x4 lo = __builtin_bit_cast(s16x4, __builtin_amdgcn_ds_read_tr16_b64_v4i16((LAS v4i16_t*)a));
    const s16x4 hi = __builtin_bit_cast(s16x4, __builtin_amdgcn_ds_read_tr16_b64_v4i16((LAS v4i16_t*)(a + 4 * stride)));
    return (bf16x8){lo[0], lo[1], lo[2], lo[3], hi[0], hi[1], hi[2], hi[3]};
}
__device__ __forceinline__ bf16x8 frag_row(const LAS unsigned char* tile, int stride, int n0, int k0, int lane) {
    return *(const LAS bf16x8*)(tile + (n0 + (lane & 15)) * stride + (k0 + 8 * (lane >> 4)) * 2);
}

__device__ __forceinline__ void mlocal_item(const Params& p, LAS unsigned char* lds, int grp, int ch, int c) {
    int tid_ = threadIdx.x; asm volatile("" : "+v"(tid_));
    const int tid = tid_, lane = tid & 63, wave = tid >> 6, wr = wave >> 2, wc = wave & 3;
    const int bl = ch >> 3, dir = (ch >> 2) & 1, h = ch & 3, gch = grp * NG * 8 + ch;
    const int oc = dir ? NCH - 1 - c : c, s0 = oc * CH;
    LAS float* wrow = (LAS float*)(lds + SC0);
    __syncthreads();
    if (tid < CH) { const int j = dir ? CH - 1 - tid : tid;
        wrow[tid] = fast_exp(gtok(p.ws, gch, GT_A)[c * CH + j] - gch_(p.ws, gch, GC_AMAX)[c]); }
    const bf16_t* AKh = (const bf16_t*)(p.ws + WS_AK) + (size_t)(bl * 4 + h) * SEQ * 256;
    const bf16_t* AVh = (const bf16_t*)(p.ws + WS_AV) + (size_t)(bl * 4 + h) * SEQ * 256;
    bf16x8 vpre[8];
    { const int cg = tid & 31, rg = tid >> 5;
#pragma unroll
      for (int r = 0; r < 8; ++r) vpre[r] = *(const bf16x8*)(AVh + (size_t)(s0 + rg * 8 + r) * 256 + cg * 8); }
    stage_conv(AKh, s0, p.ml_conv_w + 1024 + h * 256, 0.0625f, lds + R1);
    __syncthreads();
    { const int cg = tid & 31, rg = tid >> 5;
#pragma unroll
      for (int r = 0; r < 8; ++r) { const int row = rg * 8 + r; const float w = wrow[row]; const bf16x8 v = vpre[r]; u32x4 pk;
        pk.x = pg8::cvt_pk_bf16(bf2f((unsigned short)v[0]) * w, bf2f((unsigned short)v[1]) * w); pk.y = pg8::cvt_pk_bf16(bf2f((unsigned short)v[2]) * w, bf2f((unsigned short)v[3]) * w);
        pk.z = pg8::cvt_pk_bf16(bf2f((unsigned short)v[4]) * w, bf2f((unsigned short)v[5]) * w); pk.w = pg8::cvt_pk_bf16(bf2f((unsigned short)v[6]) * w, bf2f((unsigned short)v[7]) * w);
        *(LAS u32x4*)(lds + R0 + row * TS + cg * 16) = pk; } }
    __syncthreads();
    if (tid < 256) { float a0 = 0.f, a1 = 0.f, a2 = 0.f, a3 = 0.f;
#pragma unroll 2
        for (int s = 0; s < CH; s += 8) {
            float kv[8];
#pragma unroll
            for (int u = 0; u < 8; ++u) kv[u] = bf2f(*(const LAS unsigned short*)(lds + R1 + (s + u) * TS + tid * 2));
            const f32x4 w0 = *(const LAS f32x4*)(wrow + s), w1 = *(const LAS f32x4*)(wrow + s + 4);
            a0 = fmaf(w0[0], kv[0], a0); a1 = fmaf(w0[1], kv[1], a1); a2 = fmaf(w0[2], kv[2], a2); a3 = fmaf(w0[3], kv[3], a3);
            a0 = fmaf(w1[0], kv[4], a0); a1 = fmaf(w1[1], kv[5], a1); a2 = fmaf(w1[2], kv[6], a2); a3 = fmaf(w1[3], kv[7], a3);
        }
        nstate_ptr(p, gch, c)[tid] = (a0 + a1) + (a2 + a3); }
    f32x4 acc[8][4];
#pragma unroll
    for (int i = 0; i < 8; ++i)
#pragma unroll
        for (int j = 0; j < 4; ++j) acc[i][j] = (f32x4){0.f, 0.f, 0.f, 0.f};
#pragma unroll 1
    for (int ks = 0; ks < 4; ++ks) {
        bf16x8 bfr[4];
#pragma unroll
        for (int j = 0; j < 4; ++j) bfr[j] = frag_tr(lds + R0, TS, ks * 32, wc * 64 + j * 16, lane);
#pragma unroll
        for (int i = 0; i < 8; ++i) { const bf16x8 afr = frag_tr(lds + R1, TS, ks * 32, wr * 128 + i * 16, lane);
#pragma unroll
            for (int j = 0; j < 4; ++j) acc[i][j] = __builtin_amdgcn_mfma_f32_16x16x32_bf16(afr, bfr[j], acc[i][j], 0, 0, 0); }
    }
    __syncthreads();
    const int fr = lane & 15, fq = lane >> 4;
#pragma unroll
    for (int i = 0; i < 8; ++i)
#pragma unroll
        for (int j = 0; j < 4; ++j) { const int dv = wc * 64 + j * 16 + fr, dk = wr * 128 + i * 16 + 4 * fq;
            *(LAS unsigned*)(lds + dv * 272 + dk) = st_pack4(acc[i][j][0], acc[i][j][1], acc[i][j][2], acc[i][j][3]); }
    __syncthreads();
    unsigned char* C = state_ptr(p, grp, ch, c);
#pragma unroll
    for (int i = 0; i < 8; ++i) { const int e = tid + 512 * i, row = e >> 4, c16 = e & 15;
        *(u32x4*)(C + (size_t)row * 256 + c16 * 16) = *(const LAS u32x4*)(lds + row * 272 + c16 * 16); }
}
__device__ __forceinline__ void phase_mlocal(const Params& p, LAS unsigned char* lds, int grp) {
    for (int it = blockIdx.x; it < NG * 8 * NCH; it += gridDim.x) mlocal_item(p, lds, grp, it >> 6, it & 63);
}

__device__ __forceinline__ void phase_mscan(const Params& p, int grp) {
    const int gt = blockIdx.x * NTHR + opaque_tid(), NT = gridDim.x * NTHR;
    for (int v = gt; v < NG * 8 * 8192; v += NT) {
        const int ch = v >> 13, vec = v & 8191, gch = grp * NG * 8 + ch;
        const float* DE = gch_(p.ws, gch, GC_DECAY); const float* GA = gch_(p.ws, gch, GC_GAIN);
        unsigned char* base = state_ptr(p, grp, ch, 0) + (size_t)vec * 8;
        float acc[8];
#pragma unroll
        for (int e = 0; e < 8; ++e) acc[e] = 0.f;
        for (int c0 = 0; c0 < NCH; c0 += 4) {
            u32x2 d[4];
#pragma unroll
            for (int u = 0; u < 4; ++u) d[u] = *(const u32x2*)(base + (size_t)(c0 + u) * 65536);
#pragma unroll
            for (int u = 0; u < 4; ++u) {
                const float de = DE[c0 + u], ga = GA[c0 + u] * ST_ISC;
                u32x2 pk; pk.x = st_pack4(acc[0], acc[1], acc[2], acc[3]); pk.y = st_pack4(acc[4], acc[5], acc[6], acc[7]);
                *(u32x2*)(base + (size_t)(c0 + u) * 65536) = pk;
                const auto f0 = __builtin_amdgcn_cvt_pk_f32_fp8((int)d[u].x, false), f1 = __builtin_amdgcn_cvt_pk_f32_fp8((int)d[u].x, true);
                const auto f2 = __builtin_amdgcn_cvt_pk_f32_fp8((int)d[u].y, false), f3 = __builtin_amdgcn_cvt_pk_f32_fp8((int)d[u].y, true);
                acc[0] = de * acc[0] + ga * f0[0]; acc[1] = de * acc[1] + ga * f0[1]; acc[2] = de * acc[2] + ga * f1[0]; acc[3] = de * acc[3] + ga * f1[1];
                acc[4] = de * acc[4] + ga * f2[0]; acc[5] = de * acc[5] + ga * f2[1]; acc[6] = de * acc[6] + ga * f3[0]; acc[7] = de * acc[7] + ga * f3[1];
            }
        }
    }
    for (int v = gt; v < NG * 8 * 256; v += NT) {
        const int ch = v >> 8, dk = v & 255, gch = grp * NG * 8 + ch;
        const float* DE = gch_(p.ws, gch, GC_DECAY); const float* GA = gch_(p.ws, gch, GC_GAIN);
        float acc = 0.f;
        for (int c = 0; c < NCH; ++c) { float* q = nstate_ptr(p, gch, c) + dk; const float d = *q; *q = acc; acc = DE[c] * acc + GA[c] * d; }
    }
}

__device__ __forceinline__ void mout_item(const Params& p, LAS unsigned char* lds, int grp, int bl, int h, int oc) {
    int tid_ = threadIdx.x; asm volatile("" : "+v"(tid_));
    const int tid = tid_, lane = tid & 63, wave = tid >> 6, wr = wave >> 2, wc = wave & 3, fr = lane & 15, fq = lane >> 4;
    const int s0 = oc * CH, chf = (bl * 2 + 0) * 4 + h, chb = (bl * 2 + 1) * 4 + h, gf = grp * NG * 8 + chf, gb = grp * NG * 8 + chb, cb = NCH - 1 - oc;
    LAS float* SC = (LAS float*)(lds + SC0);
    LAS float* RT = SC;
    LAS float* SI = SC + 256;
    LAS float* EM = SC + 512;
    LAS float* AS = SC + 768;
    LAS float* NS = SC + 1024;
    LAS float* DENP = SC + 1536;
    LAS float* DENI = SC + 2560;
    LAS float* SS = SC + 2816;
    __syncthreads();
    if (tid < 256) {
        const int d = tid >> 7, t = tid & 127, g = d ? gb : gf, c = d ? cb : oc, pp = c * CH + (d ? CH - 1 - t : t);
        const float b = gtok(p.ws, g, GT_B)[pp], mr = gtok(p.ws, g, GT_MR)[pp], a = gtok(p.ws, g, GT_A)[pp], ms = gch_(p.ws, g, GC_MST)[c];
        const float m = fmaxf(b + ms, mr);
        RT[tid] = b - m; SI[tid] = fast_exp(b + ms - m); EM[tid] = fast_exp(-m); AS[tid] = a;
    } else {
        const int d = (tid - 256) >> 7, k2 = (tid - 256) & 127;
        const float* n = nstate_ptr(p, d ? gb : gf, d ? cb : oc);
        NS[d * 256 + 2 * k2] = n[2 * k2]; NS[d * 256 + 2 * k2 + 1] = n[2 * k2 + 1];
    }
    const bf16_t* AQh = (const bf16_t*)(p.ws + WS_AQ) + (size_t)(bl * 4 + h) * SEQ * 256;
    const bf16_t* AKh = (const bf16_t*)(p.ws + WS_AK) + (size_t)(bl * 4 + h) * SEQ * 256;
    const bf16_t* AVh = (const bf16_t*)(p.ws + WS_AV) + (size_t)(bl * 4 + h) * SEQ * 256;
    stage_conv(AQh, s0, p.ml_conv_w + h * 256, 1.f, lds + R0);
    asm volatile("" ::: "memory");
    stage_conv(AKh, s0, p.ml_conv_w + 1024 + h * 256, 0.0625f, lds + R1);
    __syncthreads();
    f32x4 sacc[2][4];
#pragma unroll
    for (int i = 0; i < 2; ++i)
#pragma unroll
        for (int j = 0; j < 4; ++j) sacc[i][j] = (f32x4){0.f, 0.f, 0.f, 0.f};
#pragma unroll
    for (int ks = 0; ks < 8; ++ks) {
        bf16x8 qf[4];
#pragma unroll
        for (int j = 0; j < 4; ++j) qf[j] = frag_row(lds + R0, TS, wr * 64 + j * 16, ks * 32, lane);
#pragma unroll
        for (int i = 0; i < 2; ++i) { const bf16x8 kf = frag_row(lds + R1, TS, wc * 32 + i * 16, ks * 32, lane);
#pragma unroll
            for (int j = 0; j < 4; ++j) sacc[i][j] = __builtin_amdgcn_mfma_f32_16x16x32_bf16(kf, qf[j], sacc[i][j], 0, 0, 0); }
    }
    {
        const int t = tid >> 2, qd = tid & 3; float df = 0.f, db = 0.f;
#pragma unroll
        for (int e8 = 0; e8 < 8; ++e8) { const bf16x8 qv = *(const LAS bf16x8*)(lds + R0 + t * TS + (qd * 64 + e8 * 8) * 2);
#pragma unroll
            for (int e = 0; e < 8; ++e) { const float q = bf2f((unsigned short)qv[e]); df = fmaf(q, NS[qd * 64 + e8 * 8 + e], df); db = fmaf(q, NS[256 + qd * 64 + e8 * 8 + e], db); } }
        df += SHX(df, 1); df += SHX(df, 2); db += SHX(db, 1); db += SHX(db, 2);
        if (qd == 0) { DENI[t] = df; DENI[128 + t] = db; }
    }
    __syncthreads();
    f32x4 acc[2][4][4];
    {
        const int e0 = tid;
        u32x4 cst[2];
#define C_SRC(s_) (state_ptr(p, grp, (s_) >= 4 ? chb : chf, (s_) >= 4 ? cb : oc) + ((s_) & 3) * 64)
#define C_LOAD(s_) do { const unsigned char* cs_ = C_SRC(s_); _Pragma("unroll") for (int i = 0; i < 2; ++i) { const int e = e0 + 512 * i; cst[i] = *(const u32x4*)(cs_ + (size_t)(e >> 2) * 256 + (e & 3) * 16); } } while (0)
#define C_CVT2(w_, lo_, hi_) do { const auto f0_ = __builtin_amdgcn_cvt_pk_f32_fp8((int)(w_), false), f1_ = __builtin_amdgcn_cvt_pk_f32_fp8((int)(w_), true); \
        lo_ = pg8::cvt_pk_bf16(f0_[0] * ST_ISC, f0_[1] * ST_ISC); hi_ = pg8::cvt_pk_bf16(f1_[0] * ST_ISC, f1_[1] * ST_ISC); } while (0)
#define C_WRITE(b_) do { _Pragma("unroll") for (int i = 0; i < 2; ++i) { const int e = e0 + 512 * i; u32x4 lo4, hi4; \
        C_CVT2(cst[i].x, lo4.x, lo4.y); C_CVT2(cst[i].y, lo4.z, lo4.w); C_CVT2(cst[i].z, hi4.x, hi4.y); C_CVT2(cst[i].w, hi4.z, hi4.w); \
        LAS unsigned char* d_ = lds + R1 + (b_) * CBUF + (e >> 2) * CS_ + (e & 3) * 32; *(LAS u32x4*)d_ = lo4; *(LAS u32x4*)(d_ + 16) = hi4; } } while (0)
        C_LOAD(0); C_WRITE(0);
        __syncthreads();
#pragma unroll
        for (int d = 0; d < 2; ++d) {
#pragma unroll
            for (int i = 0; i < 4; ++i)
#pragma unroll
                for (int j = 0; j < 4; ++j) acc[d][i][j] = (f32x4){0.f, 0.f, 0.f, 0.f};
#pragma unroll 1
            for (int q = 0; q < 4; ++q) {
                const int st = d * 4 + q;
                if (st < 7) C_LOAD(st + 1);
                const LAS unsigned char* cb_ = lds + R1 + (q & 1) * CBUF;
#pragma unroll
                for (int k2 = 0; k2 < 2; ++k2) {
                    bf16x8 cf[4], qf[4];
#pragma unroll
                    for (int i = 0; i < 4; ++i) cf[i] = frag_row(cb_, CS_, wc * 64 + i * 16, k2 * 32, lane);
#pragma unroll
                    for (int j = 0; j < 4; ++j) qf[j] = frag_row(lds + R0, TS, wr * 64 + j * 16, q * 64 + k2 * 32, lane);
#pragma unroll
                    for (int i = 0; i < 4; ++i)
#pragma unroll
                        for (int j = 0; j < 4; ++j) acc[d][i][j] = __builtin_amdgcn_mfma_f32_16x16x32_bf16(cf[i], qf[j], acc[d][i][j], 0, 0, 0);
                }
                if (st < 7) C_WRITE((q + 1) & 1);
                __syncthreads();
            }
#pragma unroll
            for (int j = 0; j < 4; ++j) { const float si = SI[d * 128 + wr * 64 + j * 16 + fr];
#pragma unroll
                for (int i = 0; i < 4; ++i) acc[d][i][j] = acc[d][i][j] * si; }
        }
#undef C_SRC
#undef C_LOAD
#undef C_CVT2
#undef C_WRITE
    }
    {
        LAS unsigned char* Pf = lds + R1; LAS unsigned char* Pb = lds + R1 + 128 * PS;
#pragma unroll
        for (int j = 0; j < 4; ++j) {
            const int t = wr * 64 + j * 16 + fr;
            const float rtf = RT[t], rtb = RT[128 + t];
            float sf = 0.f, sbw = 0.f;
#pragma unroll
            for (int i = 0; i < 2; ++i) {
                const int sb0 = wc * 32 + i * 16 + 4 * fq;
                float pf[4], pb[4];
#pragma unroll
                for (int r = 0; r < 4; ++r) { const int s = sb0 + r; const float sv = sacc[i][j][r];
                    pf[r] = (s <= t) ? sv * fast_exp(rtf + AS[s]) : 0.f;
                    pb[r] = (s >= t) ? sv * fast_exp(rtb + AS[128 + s]) : 0.f;
                    sf += pf[r]; sbw += pb[r]; }
                u32x2 a; a.x = pg8::cvt_pk_bf16(pf[0], pf[1]); a.y = pg8::cvt_pk_bf16(pf[2], pf[3]);
                u32x2 b; b.x = pg8::cvt_pk_bf16(pb[0], pb[1]); b.y = pg8::cvt_pk_bf16(pb[2], pb[3]);
                *(LAS u32x2*)(Pf + t * PS + sb0 * 2) = a; *(LAS u32x2*)(Pb + t * PS + sb0 * 2) = b;
            }
            sf += SHX(sf, 16); sf += SHX(sf, 32); sbw += SHX(sbw, 16); sbw += SHX(sbw, 32);
            if (fq == 0) { DENP[(0 * 4 + wc) * 128 + t] = sf; DENP[(1 * 4 + wc) * 128 + t] = sbw; }
        }
    }
    __syncthreads();
    stage_rows(AVh, s0, (const LAS float*)nullptr, lds + R0);
    __syncthreads();
#pragma unroll 1
    for (int ks = 0; ks < 4; ++ks) {
        bf16x8 vf[4];
#pragma unroll
        for (int i = 0; i < 4; ++i) vf[i] = frag_tr(lds + R0, TS, ks * 32, wc * 64 + i * 16, lane);
#pragma unroll
        for (int d = 0; d < 2; ++d) {
            const LAS unsigned char* P = lds + R1 + d * 128 * PS;
#pragma unroll
            for (int j = 0; j < 4; ++j) { const bf16x8 pf = frag_row(P, PS, wr * 64 + j * 16, ks * 32, lane);
#pragma unroll
                for (int i = 0; i < 4; ++i) acc[d][i][j] = __builtin_amdgcn_mfma_f32_16x16x32_bf16(vf[i], pf, acc[d][i][j], 0, 0, 0); }
        }
    }
    float ssq[4];
#pragma unroll
    for (int j = 0; j < 4; ++j) {
        const int t = wr * 64 + j * 16 + fr;
        float dn[2];
#pragma unroll
        for (int d = 0; d < 2; ++d) { const float den = (DENP[(d * 4 + 0) * 128 + t] + DENP[(d * 4 + 1) * 128 + t]) + (DENP[(d * 4 + 2) * 128 + t] + DENP[(d * 4 + 3) * 128 + t]) + SI[d * 128 + t] * DENI[d * 128 + t];
            dn[d] = __builtin_amdgcn_rcpf(fmaxf(fabsf(den), EM[d * 128 + t])); }
        float a = 0.f;
#pragma unroll
        for (int i = 0; i < 4; ++i) { const f32x4 hv = acc[0][i][j] * dn[0] + acc[1][i][j] * dn[1]; acc[0][i][j] = hv; a += (hv[0] * hv[0] + hv[1] * hv[1]) + (hv[2] * hv[2] + hv[3] * hv[3]); }
        a += SHX(a, 16); a += SHX(a, 32);
        ssq[j] = a;
        if (fq == 0) SS[wc * 128 + t] = a;
    }
    __syncthreads();
    const bf16_t* OZh = (const bf16_t*)(p.ws + WS_OZ) + ((size_t)(bl * 4 + h) * SEQ + s0) * 256;
    bf16_t* YA = (bf16_t*)(p.ws + WS_YA) + ((size_t)bl * SEQ + s0) * 1024 + h * 256;
#pragma unroll
    for (int j = 0; j < 4; ++j) {
        const int t = wr * 64 + j * 16 + fr;
        const float rs = rsqrtf(((SS[t] + SS[128 + t]) + (SS[256 + t] + SS[384 + t])) * (1.f / 256.f) + 1e-6f);
#pragma unroll
        for (int i = 0; i < 4; ++i) { const int dv = wc * 64 + i * 16 + 4 * fq;
            const f32x4 g = *(const f32x4*)(p.ml_norm_g + h * 256 + dv);
            const u32x2 oz = *(const u32x2*)(OZh + (size_t)t * 256 + dv);
            const f32x4 hv = acc[0][i][j];
            const float y0 = hv[0] * rs * g[0] * __uint_as_float(oz.x << 16), y1 = hv[1] * rs * g[1] * __uint_as_float(oz.x & 0xffff0000u);
            const float y2 = hv[2] * rs * g[2] * __uint_as_float(oz.y << 16), y3 = hv[3] * rs * g[3] * __uint_as_float(oz.y & 0xffff0000u);
            u32x2 pk; pk.x = pg8::cvt_pk_bf16(y0, y1); pk.y = pg8::cvt_pk_bf16(y2, y3);
            *(u32x2*)(YA + (size_t)t * 1024 + dv) = pk; }
        asm volatile("" ::: "memory");
    }
    (void)ssq;
}
__device__ __forceinline__ void phase_mout(const Params& p, LAS unsigned char* lds, int grp) {
    for (int it = blockIdx.x; it < NG * 4 * NCH; it += gridDim.x) mout_item(p, lds, grp, it >> 8, (it >> 6) & 3, it & 63);
}
}

__device__ __forceinline__ void phase_mix1(const Params& p, LAS unsigned char* lds, int grp) {
    pg8::Gemm g{(const bf16_t*)(p.ws + WS_YA), (const bf16_t*)(p.ws + WS_WA), TG, DM, DM};
    pg8::StaticOrder S; S.init(TG, DM, gridDim.x, (int)blockIdx.x);
    pg8::EpiMix<false> E{(const bf16_t*)(p.ws + WS_SGA), (bf16_t*)(p.ws + WS_MIX)};
    pg8::gemm_phase<pg8::EpiMix<false>, pg8::StaticOrder, true, true>(lds, g, S, E);
}
__device__ __forceinline__ void phase_mix2(const Params& p, LAS unsigned char* lds, int grp) {
    pg8::Gemm g{(const bf16_t*)(p.ws + WS_YB), (const bf16_t*)(p.ws + WS_WB), TG, DM, DM};
    pg8::StaticOrder S; S.init(TG, DM, gridDim.x, (int)blockIdx.x);
    pg8::EpiMix<true> E{(const bf16_t*)(p.ws + WS_SGB), (bf16_t*)(p.ws + WS_MIX)};
    pg8::gemm_phase<pg8::EpiMix<true>, pg8::StaticOrder, true, true>(lds, g, S, E);
}
__device__ __forceinline__ void phase_outproj(const Params& p, LAS unsigned char* lds, int grp) {
    pg8::Gemm g{(const bf16_t*)(p.ws + WS_MIX), (const bf16_t*)(p.ws + WS_WO), TG, DM, DM};
    pg8::StaticOrder S; S.init(TG, DM, gridDim.x, (int)blockIdx.x);
    pg8::EpiResid E{p.x + (size_t)grp * TG * DM, p.out + (size_t)grp * TG * DM};
    pg8::gemm_phase<pg8::EpiResid, pg8::StaticOrder, true, true>(lds, g, S, E);
}
__device__ __forceinline__ void phase_finalnorm(const Params& p, int grp) {
    const int tid = opaque_tid(), lane = tid & 63, wave = tid >> 6;
    const int gw = blockIdx.x * NWAVES + wave, NGW = gridDim.x * NWAVES;
    f32x4 vn[4];
    if (gw < TG) { const f32x4* xr0 = (const f32x4*)(p.out + ((size_t)grp * TG + gw) * DM) + lane;
#pragma unroll
        for (int j = 0; j < 4; ++j) vn[j] = xr0[64 * j]; }
    for (int m = gw; m < TG; m += NGW) {
        f32x4* xr = (f32x4*)(p.out + ((size_t)grp * TG + m) * DM) + lane;
        f32x4 v[4]; float s = 0.f;
#pragma unroll
        for (int j = 0; j < 4; ++j) { v[j] = vn[j]; s += (v[j][0] * v[j][0] + v[j][1] * v[j][1]) + (v[j][2] * v[j][2] + v[j][3] * v[j][3]); }
        if (m + NGW < TG) { const f32x4* xn = (const f32x4*)(p.out + ((size_t)grp * TG + m + NGW) * DM) + lane;
#pragma unroll
            for (int j = 0; j < 4; ++j) vn[j] = xn[64 * j]; }
        const float rstd = rsqrtf(wave_sum(s, lane) * (1.f / DM) + 1e-6f);
#pragma unroll
        for (int j = 0; j < 4; ++j) { const f32x4 g = *((const f32x4*)p.final_g + lane + 64 * j); xr[64 * j] = v[j] * rstd * g; }
    }
}
#define RLX_AGENT __ATOMIC_RELAXED, __HIP_MEMORY_SCOPE_AGENT
#define XB_TMO      128
#define XB_XCNT(j)  (256  + 64 * (j))
#define XB_XSUB(j)  (1280 + 64 * (j))
#define XB_XGEN(j)  (2304 + 64 * (j))
#define XB_TOP      3328
#define XB_TOPGEN   3392
#define XCD_BAR_WORDS 3456
#define XB_SPIN_CAP (1u << 18)

__device__ __forceinline__ unsigned xb_ld(unsigned* p)              { return __hip_atomic_load(p, __ATOMIC_RELAXED, __HIP_MEMORY_SCOPE_AGENT); }
__device__ __forceinline__ unsigned xb_add(unsigned* p, unsigned v) { return __hip_atomic_fetch_add(p, v, __ATOMIC_RELAXED, __HIP_MEMORY_SCOPE_AGENT); }
__device__ __forceinline__ unsigned xb_xcc_id() { return (unsigned)__builtin_amdgcn_s_getreg((3 << 11) | 20) & 0xFu; }
#define XB_SPIN(cond, bar) do { unsigned _sp = 0; while (cond) { __builtin_amdgcn_s_sleep(1); \
    if ((++_sp & 255u) == 0u) { if (xb_ld(&(bar)[XB_TMO])) break; if (_sp > XB_SPIN_CAP) { atomicAdd(&(bar)[XB_TMO], 1u); break; } } } } while (0)

struct XcdBarrier {
    unsigned* bar; unsigned x;
    volatile LAS unsigned* st;
};

__device__ __forceinline__ XcdBarrier xcd_barrier_post(unsigned* bar, volatile LAS unsigned* st) {
    XcdBarrier b; b.bar = bar; b.x = xb_xcc_id(); b.st = st;
    if (threadIdx.x == 0) (void)xb_add(&bar[XB_XCNT(b.x)], 1u);
    return b;
}
__device__ __forceinline__ void xcd_barrier_complete(unsigned* bar, unsigned x, unsigned& nloc, unsigned& nx) {
    const unsigned G = gridDim.x * gridDim.y * gridDim.z;
    unsigned sum, cnt, mine, sp = 0u;
    for (;;) {
        sum = 0u; cnt = 0u; mine = 0u;
#pragma unroll
        for (unsigned j = 0; j < 16; ++j) { const unsigned c = xb_ld(&bar[XB_XCNT(j)]); sum += c; cnt += (c > 0u) ? 1u : 0u; mine = (j == x) ? c : mine; }
        if (sum == G) break;
        __builtin_amdgcn_s_sleep(1);
        if ((++sp & 255u) == 0u) { if (xb_ld(&bar[XB_TMO])) break; if (sp > XB_SPIN_CAP) { atomicAdd(&bar[XB_TMO], 1u); break; } }
    }
    nloc = mine > 0u ? mine : 1u; nx = cnt > 0u ? cnt : 1u;
}

__device__ __forceinline__ void xcd_barrier(const XcdBarrier& b) {
    asm volatile("s_waitcnt vmcnt(0)" ::: "memory");
    __syncthreads();
    if (threadIdx.x == 0) {
        unsigned* bar = b.bar;
        __builtin_amdgcn_s_waitcnt(0);
        unsigned nloc = b.st[0], nx = b.st[1];
        if (nloc == 0u) { xcd_barrier_complete(bar, b.x, nloc, nx); b.st[0] = nloc; b.st[1] = nx; }
        const unsigned old = xb_add(&bar[XB_XSUB(b.x)], 1u);
        const unsigned gen = old / nloc;
        if (old + 1u == (gen + 1u) * nloc) {
            __builtin_amdgcn_fence(__ATOMIC_RELEASE, "agent");
            asm volatile("s_waitcnt vmcnt(0)" ::: "memory");
            const unsigned og = xb_add(&bar[XB_TOP], 1u);
            const unsigned tg = og / nx;
            if (og + 1u == (tg + 1u) * nx) xb_add(&bar[XB_TOPGEN], 1u);
            else XB_SPIN(xb_ld(&bar[XB_TOPGEN]) == tg, bar);
            __builtin_amdgcn_fence(__ATOMIC_ACQUIRE, "agent");
            xb_add(&bar[XB_XGEN(b.x)], 1u);
            asm volatile("s_waitcnt vmcnt(0)" ::: "memory");
        } else {
            XB_SPIN(xb_ld(&bar[XB_XGEN(b.x)]) == gen, bar);
            __builtin_amdgcn_fence(__ATOMIC_ACQUIRE, "agent");
            asm volatile("s_waitcnt vmcnt(0)" ::: "memory");
        }
    }
    __syncthreads();
}

constexpr int MISC_OFF = LDS_BYTES - 64;
__global__ void __launch_bounds__(NTHR, 2) mega_k(Params p) {
    extern __shared__ __attribute__((aligned(16))) unsigned char lds[];
    cg::grid_group grid = cg::this_grid();
    LAS unsigned char* L = (LAS unsigned char*)lds;
    volatile LAS unsigned* MISC = (volatile LAS unsigned*)(L + MISC_OFF);
    if (threadIdx.x < 16) MISC[threadIdx.x] = 0u;
    __syncthreads();
    XcdBarrier bar = xcd_barrier_post((unsigned*)(p.ws + WS_CTL) + 4096, MISC + 8);
    phase_prologue(p, L);
    grid.sync();
    for (int g = 0; g < NGRP; ++g) {
        ml::phase_gateprep(p, g);
        phase_inproj(p, L, g);
        xcd_barrier(bar);
        ml::phase_gatescan(p, L, g);
        phase_attention(p, (char*)lds, g);
        __syncthreads();
        ml::phase_mlocal(p, L, g);
        xcd_barrier(bar);
        ml::phase_mscan(p, g);
        xcd_barrier(bar);
        ml::phase_mout(p, L, g);
        xcd_barrier(bar);
        phase_mix1(p, L, g);
        __syncthreads();
        phase_mix2(p, L, g);
        xcd_barrier(bar);
        phase_outproj(p, L, g);
        xcd_barrier(bar);
        phase_finalnorm(p, g);
    }
}

extern "C" void kernel_launch(void* const* d_in, const int* in_sizes, int n_in, void* d_out, int out_size, void* d_ws, size_t ws_size, hipStream_t stream) {
    static int grid_blocks = 0;
    if (ws_size < WS_STF + GB || n_in != 14) { fprintf(stderr, "kernel_launch: needs 14 inputs and >= %zu bytes of workspace (got %d, %zu); nothing launched\n", (size_t)(WS_STF + GB), n_in, ws_size); return; }
    if (!grid_blocks) {
        int dev = 0, cus = 0, per_cu = 0;
        (void)hipGetDevice(&dev);
        (void)hipDeviceGetAttribute(&cus, hipDeviceAttributeMultiprocessorCount, dev);
        (void)hipFuncSetAttribute((const void*)mega_k, hipFuncAttributeMaxDynamicSharedMemorySize, LDS_BYTES);
        (void)hipOccupancyMaxActiveBlocksPerMultiprocessor(&per_cu, (const void*)mega_k, NTHR, LDS_BYTES);
        if (per_cu < 1) per_cu = 1;
        grid_blocks = cus * per_cu;
        if (grid_blocks > 256) grid_blocks = 256;
    }
    Params p{};
    p.x = (const float*)d_in[0]; p.pos = (const int*)d_in[1]; p.norm_g = (const float*)d_in[2]; p.w_in = (const float*)d_in[3];
    p.ml_gate_b = (const float*)d_in[4]; p.ml_conv_w = (const float*)d_in[5]; p.ml_norm_g = (const float*)d_in[6]; p.da_lambda = (const float*)d_in[7];
    p.da_subln_g = (const float*)d_in[8]; p.gate_b = (const float*)d_in[9]; p.w_a = (const float*)d_in[10]; p.w_b = (const float*)d_in[11];
    p.w_out = (const float*)d_in[12]; p.final_g = (const float*)d_in[13];
    p.out = (float*)d_out; p.ws = (unsigned char*)d_ws; p.grp = 0; p.pad = 0;
    (void)hipMemsetAsync((char*)d_ws + WS_CTL, 0, 65536, stream);
    void* args[] = {&p};
    hipError_t e = hipLaunchCooperativeKernel((const void*)mega_k, dim3(grid_blocks), dim3(NTHR), args, LDS_BYTES, stream);
    if (e != hipSuccess) fprintf(stderr, "cooperative launch failed: %s (grid %d)\n", hipGetErrorString(e), grid_blocks);
}
```

```cpp
#define MK_NG 2
#include <hip/hip_runtime.h>
#include <hip/hip_cooperative_groups.h>
#include <cstdio>
#include <cstdint>
#include <math.h>
namespace cg = cooperative_groups;

constexpr int SEQ = 8192, DM = 1024, NBATCH = 4, PW = 11280;
constexpr int TOK = NBATCH * SEQ;
#ifndef MK_NG
#define MK_NG 2
#endif
constexpr int NG = MK_NG;
constexpr int NGRP = NBATCH / NG;
constexpr int TG = NG * SEQ;
constexpr int NPROJ = 11264;
constexpr int NCH = 64, CH = 128;
constexpr int NWAVES = 8, NTHR = 512;

constexpr size_t MiB = 1u << 20;
constexpr size_t WS_CTL = 0;
constexpr size_t WS_KMAX = 32768;
constexpr size_t WS_MISC = 1 * MiB;
constexpr size_t WS_WIN = 2 * MiB;
constexpr size_t WS_WA = 24 * MiB, WS_WB = 26 * MiB, WS_WO = 28 * MiB;
constexpr size_t WS_CS = 30 * MiB;
constexpr size_t WS_GATE = 38 * MiB;
constexpr size_t WS_GTOK = 40 * MiB;
constexpr size_t WS_GCH = 44 * MiB;
constexpr size_t WS_NST = 45 * MiB;
constexpr size_t WS_HBF = 48 * MiB;
constexpr size_t GB = (size_t)NG * 16 * MiB;
constexpr size_t WS_G0 = 112 * MiB;
constexpr size_t WS_AQ = WS_G0 + 0 * GB, WS_AK = WS_G0 + 1 * GB, WS_AV = WS_G0 + 2 * GB, WS_OZ = WS_G0 + 3 * GB;
constexpr size_t WS_BV = WS_G0 + 4 * GB, WS_SBZ = WS_G0 + 5 * GB;
constexpr size_t WS_SGA = WS_G0 + 6 * GB, WS_SGB = WS_G0 + 7 * GB;
constexpr size_t WS_YA = WS_G0 + 8 * GB, WS_YB = WS_G0 + 9 * GB;
constexpr size_t WS_MIX = WS_G0 + 10 * GB;
constexpr size_t WS_END = WS_G0 + 11 * GB;
constexpr size_t WS_STF = WS_END;
static_assert(WS_STF + GB <= 512 * MiB, "fw states fit the 512 MiB workspace");
constexpr size_t DO_BQ = 128 * MiB - 2 * GB, DO_BK = 128 * MiB - GB;

#define LAS __attribute__((address_space(3)))
typedef unsigned short bf16_t;
typedef short bf16x8 __attribute__((ext_vector_type(8)));
typedef short s16x4 __attribute__((ext_vector_type(4)));
typedef float f32x4 __attribute__((ext_vector_type(4)));
typedef float f32x2 __attribute__((ext_vector_type(2)));
typedef float f32x16 __attribute__((ext_vector_type(16)));
typedef unsigned u32x4 __attribute__((ext_vector_type(4)));
typedef unsigned u32x2 __attribute__((ext_vector_type(2)));

__device__ __forceinline__ float bf2f(unsigned short v) { return __uint_as_float((unsigned)v << 16); }
__device__ __forceinline__ unsigned f2bf(float f) { unsigned u = __float_as_uint(f); return (u + 0x7fffu + ((u >> 16) & 1u)) >> 16; }
__device__ __forceinline__ unsigned pk2(float lo, float hi) { return f2bf(lo) | (f2bf(hi) << 16); }
__device__ __forceinline__ float fast_exp(float x) { return __builtin_amdgcn_exp2f(x * 1.4426950408889634f); }
__device__ __forceinline__ float fast_sigmoid(float x) { return __builtin_amdgcn_rcpf(1.f + fast_exp(-x)); }
__device__ __forceinline__ float fast_silu(float x) { return x * fast_sigmoid(x); }
#define SHX(v, off) __builtin_bit_cast(float, __builtin_amdgcn_ds_bpermute(((lane) ^ (off)) << 2, __builtin_bit_cast(int, (float)(v))))
#define SHUP(v, off) __builtin_bit_cast(float, __builtin_amdgcn_ds_bpermute(((lane) - (off)) << 2, __builtin_bit_cast(int, (float)(v))))
__device__ __forceinline__ float wave_sum(float v, int lane) {
#pragma unroll
    for (int o = 1; o < 64; o <<= 1) v += SHX(v, o);
    return v;
}

__device__ __forceinline__ int opaque_tid() { int t = threadIdx.x; asm volatile("" : "+v"(t)); return t; }

struct Params {
    const float* x; const int* pos; const float* norm_g; const float* w_in; const float* ml_gate_b; const float* ml_conv_w;
    const float* ml_norm_g; const float* da_lambda; const float* da_subln_g; const float* gate_b; const float* w_a; const float* w_b;
    const float* w_out; const float* final_g;
    float* out; unsigned char* ws;
    int grp; int pad;
};

namespace pg8 {
#define PG8_LAS __attribute__((address_space(3)))
typedef unsigned short bf16_t;
typedef short bf16x8 __attribute__((ext_vector_type(8)));
typedef float f32x4 __attribute__((ext_vector_type(4)));
typedef unsigned u32x4 __attribute__((ext_vector_type(4)));
constexpr int BM = 256, BK = 64, HALF = 128, HTB = HALF * BK * 2  , STAGE_BYTES = 8 * HTB, NXCD = 8, WGM = 8;

__host__ __device__ __forceinline__ int lds_byte(int r, int c) { const int st = (r >> 4) * 2 + (c >> 5), rr = r & 15, cc = c & 31, ob = rr * 64 + cc * 2; return st * 1024 + (ob ^ (((ob >> 9) & 1) << 5)); }
__host__ __device__ __forceinline__ void stage_rc(int b, int& R, int& C) { const int st = b / 1024, sb = b % 1024, swz = sb ^ (((sb >> 9) & 1) << 5); R = (st >> 1) * 16 + swz / 64; C = (st & 1) * 32 + (swz % 64) / 2; }
__host__ __device__ __forceinline__ int perm32(int rho) { const int n = rho >> 4, i = rho & 15; return 8 * (i >> 2) + 4 * n + (i & 3); }

struct Unit { int pm, pn; };
struct Gemm { const bf16_t* A; const bf16_t* Bt; int M, N, K; };

struct StaticOrder {
    int nM, nN, nwg, G, c;
    __host__ __device__ void init(int M, int N, int G_, int c_) { nM = M / BM; nN = N / BM; nwg = nM * nN; G = G_; c = c_; }
    __host__ __device__ bool next(int i, Unit& u) const {
        const long L = (long)i * G + c; if (L >= nwg) return false;
        int wgid = (int)L; { const int q = nwg / NXCD, r = nwg % NXCD, xcd = wgid % NXCD, off = wgid / NXCD; wgid = (xcd < r ? xcd * (q + 1) : r * (q + 1) + (xcd - r) * q) + off; }
        const int nig = WGM * nN, gid = wgid / nig, fm = gid * WGM, gsz = (nM - fm) < WGM ? (nM - fm) : WGM;
        u.pm = fm + ((wgid % nig) % gsz); u.pn = (wgid % nig) / gsz; return true;
    }
    __device__ __forceinline__ void a_ready(const Unit&) const {}
    __device__ __forceinline__ void done(const Unit&) const {}
};

typedef __bf16 bf16x2_t __attribute__((ext_vector_type(2)));
typedef float f32x2_t __attribute__((ext_vector_type(2)));
__device__ __forceinline__ unsigned cvt_pk_bf16(float lo, float hi) { f32x2_t v = {lo, hi}; bf16x2_t b = __builtin_convertvector(v, bf16x2_t); return __builtin_bit_cast(unsigned, b); }

__host__ __device__ __forceinline__ int proj_orig_col(int n) {
    const int pn = n >> 8, c = n & 255;
    if (pn < 12) return pn * 256 + c;
    if (pn < 20) { const int i = pn - 12; return (c < 128 ? 3072 : 4096) + i * 128 + (c & 127); }
    if (pn < 28) { const int base = pn < 24 ? 5136 : 6160, q = (pn - 20) & 3, cc = c & 127; return base + (4 * q + (cc >> 5)) * 64 + (c >= 128 ? 32 : 0) + (cc & 31); }
    return 7184 + (pn - 28) * 256 + c;
}
__device__ __forceinline__ void store8(bf16_t* p, const f32x4 v0, const f32x4 v1) {
    u32x4 w; w.x = cvt_pk_bf16(v0[0], v0[1]); w.y = cvt_pk_bf16(v0[2], v0[3]); w.z = cvt_pk_bf16(v1[0], v1[1]); w.w = cvt_pk_bf16(v1[2], v1[3]);
    *(u32x4*)p = w;
}
__device__ __forceinline__ f32x4 sig4(f32x4 v) { f32x4 r; r[0] = fast_sigmoid(v[0]); r[1] = fast_sigmoid(v[1]); r[2] = fast_sigmoid(v[2]); r[3] = fast_sigmoid(v[3]); return r; }
__device__ __forceinline__ f32x4 silu4(f32x4 v) { f32x4 r; r[0] = fast_silu(v[0]); r[1] = fast_silu(v[1]); r[2] = fast_silu(v[2]); r[3] = fast_silu(v[3]); return r; }

constexpr float QSCALE = 0.125f * 1.4426950408889634f;
struct EpiProj {
    static constexpr bool PERM = true, AFTER_DRAIN = false;
    unsigned char* ws; unsigned char* dout; const float* gate_b; int grp;
    __device__ __forceinline__ void operator()(const f32x4 (&acc)[2][2][4][2], const Unit& u, int wr, int wc, int fr, int fq) const {
        const int pn = u.pn;
        const int r0 = u.pm * 256 + wr * 64 + fr;
        const int bl = r0 >> 13, s0 = r0 & (SEQ - 1);
        const int c8 = wc * 32 + 8 * fq;
        if (pn < 12) {
            const int kind = pn >> 2, h = pn & 3;
            bf16_t* base = (bf16_t*)(ws + (kind == 0 ? WS_AQ : kind == 1 ? WS_AK : WS_AV)) + ((size_t)(bl * 4 + h) * SEQ + s0) * 256 + c8;
#pragma unroll
            for (int ai = 0; ai < 2; ++ai)
#pragma unroll
                for (int m = 0; m < 4; ++m)
#pragma unroll
                    for (int bj = 0; bj < 2; ++bj) store8(base + (size_t)(ai * 128 + m * 16) * 256 + bj * 128, acc[ai][bj][m][0], acc[ai][bj][m][1]);
        } else if (pn < 20) {
            const int i = pn - 12, h = i >> 1;
            bf16_t* base = (bf16_t*)(ws + WS_OZ) + ((size_t)(bl * 4 + h) * SEQ + s0) * 256 + (i & 1) * 128 + c8;
#pragma unroll
            for (int ai = 0; ai < 2; ++ai)
#pragma unroll
                for (int m = 0; m < 4; ++m)
                    store8(base + (size_t)(ai * 128 + m * 16) * 256, sig4(acc[ai][0][m][0]) * silu4(acc[ai][1][m][0]), sig4(acc[ai][0][m][1]) * silu4(acc[ai][1][m][1]));
        } else if (pn < 28) {
            const bool isq = pn < 24; const int q = (pn - 20) & 3, head = 2 * q + (wc >> 1), map = wc & 1;
            bf16_t* base = (bf16_t*)(dout + (isq ? DO_BQ : DO_BK)) + ((size_t)(bl * 8 + head) * SEQ + s0) * 128 + map * 64 + 8 * fq;
            float kn2 = 0.f; const int lane = fq * 16 + fr;
            const f32x4* cs = (const f32x4*)(ws + WS_CS) + ((size_t)(grp * TG + r0) * 32 + 8 * fq) / 2;
#pragma unroll
            for (int ai = 0; ai < 2; ++ai)
#pragma unroll
                for (int m = 0; m < 4; ++m) {
                    const int ro = ai * 128 + m * 16;
                    const f32x4* c4 = cs + (size_t)ro * 16;
                    f32x4 o1[2], o2[2];
#pragma unroll
                    for (int n = 0; n < 2; ++n) {
                        const f32x4 ca = c4[2 * n], cb = c4[2 * n + 1];
                        const f32x4 t1 = acc[ai][0][m][n], t2 = acc[ai][1][m][n];
                        o1[n][0] = t1[0] * ca[0] - t2[0] * ca[1]; o2[n][0] = t2[0] * ca[0] + t1[0] * ca[1];
                        o1[n][1] = t1[1] * ca[2] - t2[1] * ca[3]; o2[n][1] = t2[1] * ca[2] + t1[1] * ca[3];
                        o1[n][2] = t1[2] * cb[0] - t2[2] * cb[1]; o2[n][2] = t2[2] * cb[0] + t1[2] * cb[1];
                        o1[n][3] = t1[3] * cb[2] - t2[3] * cb[3]; o2[n][3] = t2[3] * cb[2] + t1[3] * cb[3];
                    }
                    if (isq) { o1[0] = o1[0] * QSCALE; o1[1] = o1[1] * QSCALE; o2[0] = o2[0] * QSCALE; o2[1] = o2[1] * QSCALE; }
                    else { float n2 = 0.f;
#pragma unroll
                        for (int n = 0; n < 2; ++n)
#pragma unroll
                            for (int j = 0; j < 4; ++j) n2 += o1[n][j] * o1[n][j] + o2[n][j] * o2[n][j];
                        n2 += SHX(n2, 16); n2 += SHX(n2, 32);
                        kn2 = fmaxf(kn2, n2); }
                    store8(base + (size_t)ro * 128, o1[0], o1[1]); store8(base + (size_t)ro * 128 + 32, o2[0], o2[1]);
                }
            if (!isq) {
                kn2 = fmaxf(kn2, SHX(kn2, 1)); kn2 = fmaxf(kn2, SHX(kn2, 2)); kn2 = fmaxf(kn2, SHX(kn2, 4)); kn2 = fmaxf(kn2, SHX(kn2, 8));
                if (fr == 0 && fq == 0) atomicMax((unsigned*)(ws + WS_KMAX) + ((size_t)(grp * NG + bl) * 8 + head) * 2 + map, __float_as_uint(kn2));
            }
        } else if (pn < 36) {
            const bool isz = pn >= 32; const int q = (pn - 28) & 3;
#pragma unroll
            for (int bj = 0; bj < 2; ++bj) {
                const int head = 2 * q + bj;
                bf16_t* base = (bf16_t*)(ws + (isz ? WS_SBZ : WS_BV)) + ((size_t)(bl * 8 + head) * SEQ + s0) * 128 + c8;
#pragma unroll
                for (int ai = 0; ai < 2; ++ai)
#pragma unroll
                    for (int m = 0; m < 4; ++m) {
                        f32x4 v0 = acc[ai][bj][m][0], v1 = acc[ai][bj][m][1];
                        if (isz) { v0 = silu4(v0); v1 = silu4(v1); }
                        store8(base + (size_t)(ai * 128 + m * 16) * 128, v0, v1);
                    }
            }
        } else {
            const bool isa = pn < 40; const int cb = ((pn - 36) & 3) * 256;
#pragma unroll
            for (int bj = 0; bj < 2; ++bj) {
                bf16_t* base = (bf16_t*)(ws + (isa ? WS_SGA : WS_SGB)) + (size_t)r0 * 1024 + cb + bj * 128 + c8;
                const float* bp = gate_b + (isa ? 0 : 1024) + cb + bj * 128 + c8;
                const f32x4 b0 = *(const f32x4*)bp, b1 = *(const f32x4*)(bp + 4);
#pragma unroll
                for (int ai = 0; ai < 2; ++ai)
#pragma unroll
                    for (int m = 0; m < 4; ++m)
                        store8(base + (size_t)(ai * 128 + m * 16) * 1024, sig4(acc[ai][bj][m][0] + b0), sig4(acc[ai][bj][m][1] + b1));
            }
        }
    }
};

__device__ __forceinline__ f32x4 bf4lo(const u32x4 w) { return (f32x4){__uint_as_float(w.x << 16), __uint_as_float(w.x & 0xffff0000u), __uint_as_float(w.y << 16), __uint_as_float(w.y & 0xffff0000u)}; }
__device__ __forceinline__ f32x4 bf4hi(const u32x4 w) { return (f32x4){__uint_as_float(w.z << 16), __uint_as_float(w.z & 0xffff0000u), __uint_as_float(w.w << 16), __uint_as_float(w.w & 0xffff0000u)}; }
template <bool ADD> struct EpiMix {
    static constexpr bool PERM = true, AFTER_DRAIN = false;
    const bf16_t* gate; bf16_t* mix;
    __device__ __forceinline__ void operator()(const f32x4 (&acc)[2][2][4][2], const Unit& u, int wr, int wc, int fr, int fq) const {
        const int r0 = u.pm * 256 + wr * 64 + fr, c0 = u.pn * 256 + wc * 32 + 8 * fq;
#pragma unroll
        for (int ai = 0; ai < 2; ++ai)
#pragma unroll
            for (int m = 0; m < 4; ++m)
#pragma unroll
                for (int bj = 0; bj < 2; ++bj) {
                    const size_t off = (size_t)(r0 + ai * 128 + m * 16) * 1024 + c0 + bj * 128;
                    const u32x4 g = *(const u32x4*)(gate + off);
                    f32x4 v0 = acc[ai][bj][m][0] * bf4lo(g), v1 = acc[ai][bj][m][1] * bf4hi(g);
                    if (ADD) { const u32x4 o = *(const u32x4*)(mix + off); v0 = v0 + bf4lo(o); v1 = v1 + bf4hi(o); }
                    store8(mix + off, v0, v1);
                }
    }
};
struct EpiResid {
    static constexpr bool PERM = false, AFTER_DRAIN = false;
    const float* resid; float* out;
    __device__ __forceinline__ void operator()(const f32x4 (&acc)[2][2][4][2], const Unit& u, int wr, int wc, int fr, int fq) const {
        const int r0 = u.pm * 256 + wr * 64 + fr, c0 = u.pn * 256 + wc * 32 + 4 * fq;
#pragma unroll
        for (int ai = 0; ai < 2; ++ai)
#pragma unroll
            for (int m = 0; m < 4; ++m)
#pragma unroll
                for (int bj = 0; bj < 2; ++bj)
#pragma unroll
                    for (int n = 0; n < 2; ++n) {
                        const size_t off = (size_t)(r0 + ai * 128 + m * 16) * 1024 + c0 + bj * 128 + n * 16;
                        *(f32x4*)(out + off) = *(const f32x4*)(resid + off) + acc[ai][bj][m][n];
                    }
    }
};
template <class Epi, class Sched, bool ALIGN_EPI = false, bool SP2 = false>
__device__ __forceinline__ void gemm_phase(PG8_LAS unsigned char* lds, const Gemm g, const Sched& S, const Epi& E) {
    const int tid = opaque_tid(), wid = __builtin_amdgcn_readfirstlane(tid >> 6), lane = tid & 63, wr = wid >> 2, wc = wid & 3, fr = lane & 15, fq = lane >> 4;
    const int K = g.K, nt = K / BK;
    unsigned voffA[2], voffB[2];
#pragma unroll
    for (int i = 0; i < 2; ++i) { int R, C; stage_rc(tid * 16 + i * 8192, R, C); const int Rb = Epi::PERM ? ((R & ~31) + perm32(R & 31)) : R;
        voffA[i] = (unsigned)(R * K + C) * 2u; voffB[i] = (unsigned)(Rb * K + C) * 2u; }
    const size_t kstep = (size_t)(BK * 2);
    const size_t hstep = (size_t)HALF * K * 2;
    const size_t tstep = 2 * hstep;
    const unsigned ldsw = (unsigned)wid * 1024u;
    const int aoff = lds_byte(wr * 64 + fr, fq * 8), boff = lds_byte(wc * 32 + fr, fq * 8);
#define PG8_SA(b, h) (((b) * 2 + (h)) * HTB)
#define PG8_SB(b, h) ((4 + (b) * 2 + (h)) * HTB)
#define PG8_STAGE(bufoff, gbase, voff) do { _Pragma("unroll") for (int _i = 0; _i < 2; ++_i) \
        __builtin_amdgcn_global_load_lds((const unsigned*)((const char*)(gbase) + (voff)[_i]), (PG8_LAS unsigned*)(lds + (bufoff) + ldsw + _i * 8192), 16, 0, 0); } while (0)
#define PG8_LDA(dst, b, h) do { _Pragma("unroll") for (int m = 0; m < 4; ++m) _Pragma("unroll") for (int k = 0; k < 2; ++k) dst[m][k] = *(const PG8_LAS bf16x8*)(lds + PG8_SA(b, h) + aoff + m * 2048 + k * 1024); } while (0)
#define PG8_LDB(dst, b, h) do { _Pragma("unroll") for (int n = 0; n < 2; ++n) _Pragma("unroll") for (int k = 0; k < 2; ++k) dst[n][k] = *(const PG8_LAS bf16x8*)(lds + PG8_SB(b, h) + boff + n * 2048 + k * 1024); } while (0)
#define PG8_MMA(ai, bj, At, Bt) do { __builtin_amdgcn_s_setprio(1); _Pragma("unroll") for (int m = 0; m < 4; ++m) _Pragma("unroll") for (int n = 0; n < 2; ++n) _Pragma("unroll") for (int k = 0; k < 2; ++k) \
        acc[ai][bj][m][n] = __builtin_amdgcn_mfma_f32_16x16x32_bf16(Bt[n][k], At[m][k], acc[ai][bj][m][n], 0, 0, 0); __builtin_amdgcn_s_setprio(0); } while (0)
#define PG8_WAIT_V(n) asm volatile("s_waitcnt vmcnt(" #n ")" ::: "memory")
#define PG8_WAIT_L(n) asm volatile("s_waitcnt lgkmcnt(" #n ")" ::: "memory")
#define PG8_BAR __builtin_amdgcn_s_barrier()
#define PG8_SCHED __builtin_amdgcn_sched_barrier(0)
    Unit cur, nxt; int ui = 0;
    if (!S.next(0, cur)) return;
    f32x4 acc[2][2][4][2];
#pragma unroll
    for (int a = 0; a < 2; ++a)
#pragma unroll
        for (int b = 0; b < 2; ++b)
#pragma unroll
            for (int m = 0; m < 4; ++m)
#pragma unroll
                for (int n = 0; n < 2; ++n) acc[a][b][m][n] = (f32x4){0.f, 0.f, 0.f, 0.f};
    bf16x8 At[4][2], B0[2][2], B1[2][2];
    const char* cA = (const char*)g.A + (size_t)cur.pm * tstep; const char* cB = (const char*)g.Bt + (size_t)cur.pn * tstep;
    S.a_ready(cur);
    if constexpr (SP2) {
        PG8_STAGE(PG8_SB(0, 0), cB, voffB); PG8_STAGE(PG8_SB(0, 1), cB + hstep, voffB); PG8_STAGE(PG8_SA(0, 0), cA, voffA); PG8_STAGE(PG8_SA(0, 1), cA + hstep, voffA);
        if (wr == 1) PG8_BAR;
        PG8_WAIT_V(2); PG8_BAR;
        PG8_STAGE(PG8_SB(1, 0), cB + kstep, voffB); PG8_STAGE(PG8_SA(1, 0), cA + kstep, voffA); PG8_STAGE(PG8_SB(1, 1), cB + hstep + kstep, voffB);
        PG8_WAIT_V(6); PG8_BAR;
    } else {
        PG8_STAGE(PG8_SB(0, 0), cB, voffB); PG8_STAGE(PG8_SA(0, 0), cA, voffA); PG8_STAGE(PG8_SB(0, 1), cB + hstep, voffB); PG8_STAGE(PG8_SA(0, 1), cA + hstep, voffA);
        if (wr == 1) PG8_BAR;
        PG8_WAIT_V(4); PG8_BAR;
        PG8_STAGE(PG8_SB(1, 0), cB + kstep, voffB); PG8_STAGE(PG8_SA(1, 0), cA + kstep, voffA); PG8_STAGE(PG8_SB(1, 1), cB + hstep + kstep, voffB);
        PG8_WAIT_V(6); PG8_BAR;
    }
    for (;;) {
        const bool has_next = S.next(ui + 1, nxt);
        const char* nA = has_next ? (const char*)g.A + (size_t)nxt.pm * tstep : cA; const char* nB = has_next ? (const char*)g.Bt + (size_t)nxt.pn * tstep : cB;
        for (int t = 0; t < nt; t += 2) {
            const bool last = (t == nt - 2);
            const char* a1 = cA + (size_t)(t + 1) * kstep;
            const char* a2 = last ? nA : cA + (size_t)(t + 2) * kstep; const char* b2 = last ? nB : cB + (size_t)(t + 2) * kstep;
            const char* a3 = a2 + kstep; const char* b3 = b2 + kstep;
            if (last && has_next) S.a_ready(nxt);
            if constexpr (SP2) {
            PG8_LDB(B0, 0, 0); PG8_LDB(B1, 0, 1); PG8_SCHED; PG8_LDA(At, 0, 0); PG8_STAGE(PG8_SA(1, 1), a1 + hstep, voffA);
            PG8_WAIT_V(8); PG8_WAIT_L(0); PG8_BAR; PG8_MMA(0, 0, At, B0); PG8_MMA(0, 1, At, B1); PG8_BAR; PG8_SCHED;
            PG8_LDA(At, 0, 1); PG8_STAGE(PG8_SB(0, 0), b2, voffB); PG8_STAGE(PG8_SB(0, 1), b2 + hstep, voffB); PG8_STAGE(PG8_SA(0, 0), a2, voffA);
            PG8_WAIT_V(8); PG8_WAIT_L(0); PG8_BAR; PG8_MMA(1, 0, At, B0); PG8_MMA(1, 1, At, B1); PG8_BAR; PG8_SCHED;
            PG8_LDB(B0, 1, 0); PG8_LDB(B1, 1, 1); PG8_SCHED; PG8_LDA(At, 1, 0); PG8_STAGE(PG8_SA(0, 1), a2 + hstep, voffA);
            PG8_WAIT_V(8); PG8_WAIT_L(0); PG8_BAR; PG8_MMA(0, 0, At, B0); PG8_MMA(0, 1, At, B1); PG8_BAR; PG8_SCHED;
            PG8_LDA(At, 1, 1); PG8_STAGE(PG8_SB(1, 0), b3, voffB); PG8_STAGE(PG8_SB(1, 1), b3 + hstep, voffB); PG8_STAGE(PG8_SA(1, 0), a3, voffA);
            PG8_WAIT_V(8); PG8_WAIT_L(0); PG8_BAR; PG8_MMA(1, 0, At, B0); PG8_MMA(1, 1, At, B1); PG8_BAR; PG8_SCHED;
            } else {
            PG8_LDB(B0, 0, 0); PG8_SCHED; PG8_LDA(At, 0, 0); PG8_STAGE(PG8_SA(1, 1), a1 + hstep, voffA);
            PG8_WAIT_L(8); PG8_BAR; PG8_WAIT_L(0); PG8_MMA(0, 0, At, B0); PG8_BAR; PG8_SCHED;
            PG8_LDB(B1, 0, 1); PG8_STAGE(PG8_SB(0, 0), b2, voffB);
            PG8_BAR; PG8_WAIT_L(0); PG8_MMA(0, 1, At, B1); PG8_BAR;
            PG8_LDA(At, 0, 1); PG8_STAGE(PG8_SA(0, 0), a2, voffA);
            PG8_BAR; PG8_WAIT_L(0); PG8_MMA(1, 0, At, B0); PG8_BAR; PG8_SCHED;
            PG8_STAGE(PG8_SB(0, 1), b2 + hstep, voffB);
            PG8_WAIT_V(6); PG8_BAR; PG8_MMA(1, 1, At, B1); PG8_BAR;
            PG8_LDB(B0, 1, 0); PG8_SCHED; PG8_LDA(At, 1, 0); PG8_STAGE(PG8_SA(0, 1), a2 + hstep, voffA);
            PG8_WAIT_L(8); PG8_BAR; PG8_WAIT_L(0); PG8_MMA(0, 0, At, B0); PG8_BAR; PG8_SCHED;
            PG8_LDB(B1, 1, 1); PG8_STAGE(PG8_SB(1, 0), b3, voffB);
            PG8_BAR; PG8_WAIT_L(0); PG8_MMA(0, 1, At, B1); PG8_BAR;
            PG8_LDA(At, 1, 1); PG8_STAGE(PG8_SA(1, 0), a3, voffA);
            PG8_BAR; PG8_WAIT_L(0); PG8_MMA(1, 0, At, B0); PG8_BAR; PG8_SCHED;
            PG8_STAGE(PG8_SB(1, 1), b3 + hstep, voffB);
            PG8_WAIT_V(6); PG8_BAR; PG8_MMA(1, 1, At, B1); PG8_BAR;
            }
        }
        if constexpr (ALIGN_EPI) { if (wr == 0) PG8_BAR; }
        if constexpr (!Epi::AFTER_DRAIN) { E(acc, cur, wr, wc, fr, fq); S.done(cur); }
        if (!has_next) break;
#pragma unroll
        for (int a = 0; a < 2; ++a)
#pragma unroll
            for (int b = 0; b < 2; ++b)
#pragma unroll
                for (int m = 0; m < 4; ++m)
#pragma unroll
                    for (int n = 0; n < 2; ++n) acc[a][b][m][n] = (f32x4){0.f, 0.f, 0.f, 0.f};
        cur = nxt; cA = nA; cB = nB; ++ui;
        if constexpr (ALIGN_EPI) { if (wr == 1) PG8_BAR; }
    }
    PG8_WAIT_V(0);
    if constexpr (!ALIGN_EPI) { if (wr == 0) PG8_BAR; }
    PG8_BAR;
    if constexpr (Epi::AFTER_DRAIN) { E.fused(acc, cur, wr, wc, fr, fq, lds, wid, lane); S.done(cur); }
#undef PG8_SA
#undef PG8_SB
#undef PG8_STAGE
#undef PG8_LDA
#undef PG8_LDB
#undef PG8_MMA
#undef PG8_WAIT_V
#undef PG8_WAIT_L
#undef PG8_BAR
#undef PG8_SCHED
}
}

constexpr int LDS_BYTES = 163840;

__device__ __forceinline__ int vcu_of(int bx, int G) { return (G % 8 == 0) ? (bx % 8) * (G / 8) + bx / 8 : bx; }

__device__ __forceinline__ void p0_transpose_item(const float* W, int ldw, int col0, int k0, bf16_t* WTrow0, int K, LAS float* scr, int lane) {
#pragma unroll 8
    for (int i = 0; i < 32; ++i) { const int kk = 2 * i + (lane >> 5); scr[kk * 33 + (lane & 31)] = W[(size_t)(k0 + kk) * ldw + col0 + (lane & 31)]; }
    asm volatile("s_waitcnt lgkmcnt(0)" ::: "memory");
    const int c = lane & 7;
#pragma unroll
    for (int j = 0; j < 4; ++j) { const int n = (lane >> 3) + 8 * j; const LAS float* s = scr + (8 * c) * 33 + n;
        u32x4 o; o.x = pk2(s[0 * 33], s[1 * 33]); o.y = pk2(s[2 * 33], s[3 * 33]); o.z = pk2(s[4 * 33], s[5 * 33]); o.w = pk2(s[6 * 33], s[7 * 33]);
        *(u32x4*)(WTrow0 + (size_t)n * K + k0 + 8 * c) = o; }
    asm volatile("s_waitcnt lgkmcnt(0)" ::: "memory");
}

__device__ __forceinline__ void phase_prologue(const Params& p, LAS unsigned char* lds) {
    const int tid = opaque_tid(), lane = tid & 63, wave = __builtin_amdgcn_readfirstlane(tid >> 6);
    const int G = gridDim.x, gw = blockIdx.x * NWAVES + wave, NGW = G * NWAVES;
    unsigned char* ws = p.ws;
    {
        LAS float* scr = (LAS float*)(lds + wave * 16384);
        constexpr int I_IN = 16 * (NPROJ / 32), I_SQ = 16 * 32;
        for (int it = gw; it < I_IN + 3 * I_SQ; it += NGW) {
            if (it < I_IN) { const int kb = it / (NPROJ / 32), nb = it % (NPROJ / 32);
                p0_transpose_item(p.w_in, PW, pg8::proj_orig_col(nb * 32), kb * 64, (bf16_t*)(ws + WS_WIN) + (size_t)(nb * 32) * DM, DM, scr, lane); }
            else { const int r = it - I_IN, wsel = r / I_SQ, rr = r % I_SQ, kb = rr / 32, nb = rr % 32;
                const float* W = wsel == 0 ? p.w_a : wsel == 1 ? p.w_b : p.w_out;
                bf16_t* WT = (bf16_t*)(ws + (wsel == 0 ? WS_WA : wsel == 1 ? WS_WB : WS_WO));
                p0_transpose_item(W, DM, nb * 32, kb * 64, WT + (size_t)(nb * 32) * DM, DM, scr, lane); }
        }
    }
    for (int e = blockIdx.x * NTHR + tid; e < TOK * 32; e += G * NTHR) {
        const int t = e >> 5, i = e & 31;
        const float inv = (float)exp(-(double)(2 * i) * (9.210340371976184 / 64.0));
        const float ang = (float)p.pos[t] * inv;
        double rev = (double)ang * 0.15915494309189535; rev -= rint(rev);
        f32x2 cs; cs.x = __builtin_amdgcn_cosf((float)rev); cs.y = __builtin_amdgcn_sinf((float)rev);
        ((f32x2*)(ws + WS_CS))[e] = cs;
    }
    if (blockIdx.x == 0 && tid == 0) {
        float a = 0.f, b = 0.f;
        for (int i = 0; i < 64; ++i) { a += p.da_lambda[i] * p.da_lambda[64 + i]; b += p.da_lambda[128 + i] * p.da_lambda[192 + i]; }
        ((float*)(ws + WS_MISC))[0] = expf(a) - expf(b) + 0.2f;
    }
    __syncthreads();
    LAS float* wg = (LAS float*)lds;
    for (int k = tid; k < DM; k += NTHR) {
        const float* src = p.w_in + (size_t)k * PW + 5120;
#pragma unroll
        for (int q = 0; q < 4; ++q) { const f32x4 v = *(const f32x4*)(src + 4 * q);
            wg[(4 * q + 0) * DM + k] = v[0]; wg[(4 * q + 1) * DM + k] = v[1]; wg[(4 * q + 2) * DM + k] = v[2]; wg[(4 * q + 3) * DM + k] = v[3]; }
    }
    __syncthreads();
    f32x4 vn[4];
    if (gw < TOK) { const f32x4* xr = (const f32x4*)(p.x + (size_t)gw * DM) + lane;
#pragma unroll
        for (int j = 0; j < 4; ++j) vn[j] = xr[64 * j]; }
    for (int m = gw; m < TOK; m += NGW) {
        f32x4 v[4]; float s = 0.f;
#pragma unroll
        for (int j = 0; j < 4; ++j) { v[j] = vn[j]; s += (v[j][0] * v[j][0] + v[j][1] * v[j][1]) + (v[j][2] * v[j][2] + v[j][3] * v[j][3]); }
        if (m + NGW < TOK) { const f32x4* xr = (const f32x4*)(p.x + (size_t)(m + NGW) * DM) + lane;
#pragma unroll
            for (int j = 0; j < 4; ++j) vn[j] = xr[64 * j]; }
        const float rstd = rsqrtf(wave_sum(s, lane) * (1.f / DM) + 1e-6f);
#pragma unroll
        for (int j = 0; j < 4; ++j) { const f32x4 g = *((const f32x4*)p.norm_g + lane + 64 * j); v[j] = v[j] * rstd * g; }
        unsigned long long* o8 = (unsigned long long*)((bf16_t*)(ws + WS_HBF) + (size_t)m * DM) + lane;
#pragma unroll
        for (int j = 0; j < 4; ++j) o8[64 * j] = (unsigned long long)pk2(v[j][0], v[j][1]) | ((unsigned long long)pk2(v[j][2], v[j][3]) << 32);
        float mine = 0.f;
#pragma unroll
        for (int gi = 0; gi < 16; ++gi) {
            float a = 0.f;
            asm volatile("" ::: "memory");
#pragma unroll
            for (int j = 0; j < 4; ++j) { const f32x4 w = *(const LAS f32x4*)(wg + gi * DM + 4 * lane + 256 * j); a += (v[j][0] * w[0] + v[j][1] * w[1]) + (v[j][2] * w[2] + v[j][3] * w[3]); }
            a = wave_sum(a, lane);
            if (lane == gi) mine = a;
        }
        if (lane < 16) ((float*)(ws + WS_GATE))[(size_t)m * 16 + lane] = mine;
    }
}

__device__ __forceinline__ void phase_inproj(const Params& p, LAS unsigned char* lds, int grp) {
    pg8::Gemm g{(const bf16_t*)(p.ws + WS_HBF) + (size_t)grp * TG * DM, (const bf16_t*)(p.ws + WS_WIN), TG, NPROJ, DM};
    pg8::StaticOrder S; S.init(TG, NPROJ, gridDim.x, (int)blockIdx.x);
    pg8::EpiProj E{p.ws, (unsigned char*)p.out, p.gate_b, grp};
    pg8::gemm_phase<pg8::EpiProj, pg8::StaticOrder, true, true>(lds, g, S, E);
}

namespace att {
constexpr int KVBLK = 64;
constexpr float SCALE = 0.125f, THR = 8.f;
constexpr int SHM_V = KVBLK * 128 * 2, SHM_K = KVBLK * 128 * 2, SHM_ATTN = 2 * SHM_V + 2 * SHM_K + NWAVES * 64 * 4;
#define KSWZ(row, colB) ((row) * 256 + ((colB) ^ (((row) & 7) << 4)))
#define SBAR() __builtin_amdgcn_sched_barrier(0)
__device__ __forceinline__ int crow(int r, int hi) { return (r & 3) + 8 * (r >> 2) + 4 * hi; }
__device__ __forceinline__ unsigned cvtpk(float lo, float hi) { return pg8::cvt_pk_bf16(lo, hi); }

__device__ __forceinline__ void expHalf(f32x16& p) {
#pragma unroll
    for (int r = 0; r < 16; ++r) p[r] = __builtin_amdgcn_exp2f(p[r]);
}
__device__ __forceinline__ void packP(const f32x16& p0, const f32x16& p1, bf16x8& pa0, bf16x8& pa1, bf16x8& pa2, bf16x8& pa3) {
#define PK4(P, BASE, OUT) do { unsigned a0 = cvtpk(P[BASE + 0], P[BASE + 1]), a1 = cvtpk(P[BASE + 2], P[BASE + 3]);   \
    unsigned b0 = cvtpk(P[BASE + 4], P[BASE + 5]), b1 = cvtpk(P[BASE + 6], P[BASE + 7]);                              \
    auto r0 = __builtin_amdgcn_permlane32_swap(a0, b0, false, false); auto r1 = __builtin_amdgcn_permlane32_swap(a1, b1, false, false); \
    u32x4 w = {r0[0], r1[0], r0[1], r1[1]}; OUT = *reinterpret_cast<bf16x8*>(&w); } while (0)
    PK4(p0, 0, pa0); PK4(p0, 8, pa1); PK4(p1, 0, pa2); PK4(p1, 8, pa3);
#undef PK4
}
__device__ __forceinline__ void qkt(f32x16& p0, f32x16& p1, const char* Ks, const bf16x8* qr, float negm, int g, int r32, int hi) {
#pragma unroll
    for (int r = 0; r < 16; ++r) { p0[r] = negm; p1[r] = negm; }
#pragma unroll
    for (int d0 = 0; d0 < 4; ++d0) { const int cb = ((g * 4 + d0) * 16 + hi * 8) * 2;
        const bf16x8 b0 = *reinterpret_cast<const bf16x8*>(Ks + KSWZ(r32, cb));
        const bf16x8 b1 = *reinterpret_cast<const bf16x8*>(Ks + KSWZ(32 + r32, cb));
        p0 = __builtin_amdgcn_mfma_f32_32x32x16_bf16(b0, qr[d0], p0, 0, 0, 0);
        p1 = __builtin_amdgcn_mfma_f32_32x32x16_bf16(b1, qr[d0], p1, 0, 0, 0); }
}
__device__ __forceinline__ int v_st(int k, int c) { const int kk = (k & ~0xC) | ((k & 4) << 1) | ((k & 8) >> 1); return ((kk >> 3) * 4 + (c >> 5)) * 512 + ((kk & 7) * 32 + (c & 31)) * 2; }
__device__ __forceinline__ int v_rd_base(int lane) { return ((lane & 3) << 3) | (((lane >> 2) & 3) << 6) | (((lane >> 4) & 1) << 5) | (((lane >> 5) & 1) << 8); }
constexpr int v_rd_off(int d0, int ks, int half) { return d0 * 512 + ks * 4096 + half * 2048; }
template <int OFF> __device__ __forceinline__ s16x4 tr_read(int vb) {
    s16x4 r; asm volatile("ds_read_b64_tr_b16 %0, %1 offset:%2" : "=&v"(r) : "v"(vb), "i"(OFF) : "memory"); return r;
}
#define PV_LOAD8(R, D0) const s16x4 R##0 = tr_read<v_rd_off(D0, 0, 0)>(vb), R##1 = tr_read<v_rd_off(D0, 0, 1)>(vb), R##2 = tr_read<v_rd_off(D0, 1, 0)>(vb), R##3 = tr_read<v_rd_off(D0, 1, 1)>(vb), \
    R##4 = tr_read<v_rd_off(D0, 2, 0)>(vb), R##5 = tr_read<v_rd_off(D0, 2, 1)>(vb), R##6 = tr_read<v_rd_off(D0, 3, 0)>(vb), R##7 = tr_read<v_rd_off(D0, 3, 1)>(vb)
#define PV_PK(L, H) (bf16x8){L[0], L[1], L[2], L[3], H[0], H[1], H[2], H[3]}
#define PV_MMA4(OD, R) do { OD = __builtin_amdgcn_mfma_f32_32x32x16_bf16(pa0, PV_PK(R##0, R##1), OD, 0, 0, 0); OD = __builtin_amdgcn_mfma_f32_32x32x16_bf16(pa1, PV_PK(R##2, R##3), OD, 0, 0, 0); \
    OD = __builtin_amdgcn_mfma_f32_32x32x16_bf16(pa2, PV_PK(R##4, R##5), OD, 0, 0, 0); OD = __builtin_amdgcn_mfma_f32_32x32x16_bf16(pa3, PV_PK(R##6, R##7), OD, 0, 0, 0); } while (0)
__device__ __forceinline__ void pv_d0(f32x16* o, f32x16& lacc, int vb, bf16x8 pa0, bf16x8 pa1, bf16x8 pa2, bf16x8 pa3) {
    const bf16x8 ones = {0x3F80, 0x3F80, 0x3F80, 0x3F80, 0x3F80, 0x3F80, 0x3F80, 0x3F80};
    PV_LOAD8(a, 0); SBAR();
    lacc = __builtin_amdgcn_mfma_f32_32x32x16_bf16(pa0, ones, lacc, 0, 0, 0); lacc = __builtin_amdgcn_mfma_f32_32x32x16_bf16(pa1, ones, lacc, 0, 0, 0);
    lacc = __builtin_amdgcn_mfma_f32_32x32x16_bf16(pa2, ones, lacc, 0, 0, 0); lacc = __builtin_amdgcn_mfma_f32_32x32x16_bf16(pa3, ones, lacc, 0, 0, 0);
    SBAR(); PV_LOAD8(b, 1); asm volatile("s_waitcnt lgkmcnt(8)" ::: "memory"); SBAR(); PV_MMA4(o[0], a);
    SBAR(); PV_LOAD8(c, 2); asm volatile("s_waitcnt lgkmcnt(8)" ::: "memory"); SBAR(); PV_MMA4(o[1], b);
    SBAR(); PV_LOAD8(d, 3); asm volatile("s_waitcnt lgkmcnt(8)" ::: "memory"); SBAR(); PV_MMA4(o[2], c);
    asm volatile("s_waitcnt lgkmcnt(0)" ::: "memory"); SBAR(); PV_MMA4(o[3], d);
}
#undef PV_LOAD8
#undef PV_PK
#undef PV_MMA4

#define TR_LOAD8(R, D0) do { R##0 = tr_read<v_rd_off(D0, 0, 0)>(vb); R##1 = tr_read<v_rd_off(D0, 0, 1)>(vb); R##2 = tr_read<v_rd_off(D0, 1, 0)>(vb); R##3 = tr_read<v_rd_off(D0, 1, 1)>(vb); \
    R##4 = tr_read<v_rd_off(D0, 2, 0)>(vb); R##5 = tr_read<v_rd_off(D0, 2, 1)>(vb); R##6 = tr_read<v_rd_off(D0, 3, 0)>(vb); R##7 = tr_read<v_rd_off(D0, 3, 1)>(vb); } while (0)
#define TR_PK(L, H) (bf16x8){L[0], L[1], L[2], L[3], H[0], H[1], H[2], H[3]}
#define TR_MMA4(OD, R) do { OD = __builtin_amdgcn_mfma_f32_32x32x16_bf16(po0, TR_PK(R##0, R##1), OD, 0, 0, 0); OD = __builtin_amdgcn_mfma_f32_32x32x16_bf16(po1, TR_PK(R##2, R##3), OD, 0, 0, 0); \
    OD = __builtin_amdgcn_mfma_f32_32x32x16_bf16(po2, TR_PK(R##4, R##5), OD, 0, 0, 0); OD = __builtin_amdgcn_mfma_f32_32x32x16_bf16(po3, TR_PK(R##6, R##7), OD, 0, 0, 0); } while (0)
#define EXP8(P, B) do { _Pragma("unroll") for (int _r = 0; _r < 8; ++_r) P[(B) + _r] = __builtin_amdgcn_exp2f(P[(B) + _r]); } while (0)
#define SUM8(P, B) do { ls[0] += P[(B) + 0] + P[(B) + 4]; ls[1] += P[(B) + 1] + P[(B) + 5]; ls[2] += P[(B) + 2] + P[(B) + 6]; ls[3] += P[(B) + 3] + P[(B) + 7]; } while (0)
#define CVT4(P, B, W) do { W[0] = cvtpk(P[(B) + 0], P[(B) + 1]); W[1] = cvtpk(P[(B) + 2], P[(B) + 3]); W[2] = cvtpk(P[(B) + 4], P[(B) + 5]); W[3] = cvtpk(P[(B) + 6], P[(B) + 7]); } while (0)
#define SWAP4(W, OUT) do { auto _r0 = __builtin_amdgcn_permlane32_swap(W[0], W[2], false, false); auto _r1 = __builtin_amdgcn_permlane32_swap(W[1], W[3], false, false); \
    u32x4 _w = {_r0[0], _r1[0], _r0[1], _r1[1]}; OUT = *reinterpret_cast<bf16x8*>(&_w); } while (0)
#define WAITL0() asm volatile("s_waitcnt lgkmcnt(0)" ::: "memory")
#define TRL(R, D0, I0, I1, I2, I3) do { R##I0 = tr_read<v_rd_off(D0, I0 >> 1, I0 & 1)>(vb); R##I1 = tr_read<v_rd_off(D0, I1 >> 1, I1 & 1)>(vb); R##I2 = tr_read<v_rd_off(D0, I2 >> 1, I2 & 1)>(vb); R##I3 = tr_read<v_rd_off(D0, I3 >> 1, I3 & 1)>(vb); } while (0)
#define MMO(OD, PO, L, H) OD = __builtin_amdgcn_mfma_f32_32x32x16_bf16(PO, TR_PK(L, H), OD, 0, 0, 0)
#define EX(P, I) P[I] = __builtin_amdgcn_exp2f(P[I])
#define AD(P, I) do { ls[(I) & 3] += P[I]; asm volatile("" : "+v"(ls[(I) & 3])); } while (0)
#define CV(W, J, P, I) W[J] = cvtpk(P[I], P[(I) + 1])
#define KLD(DST, D0) do { const int _cb = ((g * 4 + (D0)) * 16 + hi * 8) * 2; DST[0] = *reinterpret_cast<const bf16x8*>(Ks + KSWZ(r32, _cb)); DST[1] = *reinterpret_cast<const bf16x8*>(Ks + KSWZ(32 + r32, _cb)); } while (0)
template <bool DO_QT, bool DO_QK, bool DO_SM, bool DO_PV, bool DK, bool DV>
__device__ __forceinline__ void step3(bf16x8 (&kc)[2][2], const bf16_t* kg, const bf16_t* vg, char* kd, char* vd, unsigned koff, unsigned voff, f32x16* o, float (&ls)[4], int vb, const char* Ks, const bf16x8* qr, float negm, int g, int r32, int hi, f32x16& c0, f32x16& c1, f32x16& n0, f32x16& n1,
                                      bf16x8 po0, bf16x8 po1, bf16x8 po2, bf16x8 po3, bf16x8& pn0, bf16x8& pn1, bf16x8& pn2, bf16x8& pn3) {
    s16x4 a0, a1, a2, a3, a4, a5, a6, a7, b0, b1, b2, b3, b4, b5, b6, b7;
    unsigned w0[4], w1[4], w2[4], w3[4];
    bf16x8 kf[2][2];
#define TR2(R, D0, I0, I1) do { R##I0 = tr_read<v_rd_off(D0, I0 >> 1, I0 & 1)>(vb); R##I1 = tr_read<v_rd_off(D0, I1 >> 1, I1 & 1)>(vb); } while (0)
#define WAITL(N) asm volatile("s_waitcnt lgkmcnt(" #N ")" ::: "memory")
    if constexpr (DO_PV) TRL(a, 0, 0, 1, 2, 3);
    if constexpr (DO_QT) c0 = __builtin_amdgcn_mfma_f32_32x32x16_bf16(kc[0][0], qr[2], c0, 0, 0, 0);
    SBAR();
    if constexpr (DO_PV) TRL(a, 0, 4, 5, 6, 7);
    if constexpr (DO_QT) c1 = __builtin_amdgcn_mfma_f32_32x32x16_bf16(kc[0][1], qr[2], c1, 0, 0, 0);
    SBAR();
    if constexpr (DO_PV) TRL(b, 1, 0, 1, 2, 3);
    if constexpr (DK) __builtin_amdgcn_global_load_lds((const unsigned*)(kg + koff), (LAS unsigned*)kd, 16, 0, 0);
    if constexpr (DO_QT) c0 = __builtin_amdgcn_mfma_f32_32x32x16_bf16(kc[1][0], qr[3], c0, 0, 0, 0);
    SBAR();
    if constexpr (DO_PV) TRL(b, 1, 4, 5, 6, 7);
    if constexpr (DO_QT) c1 = __builtin_amdgcn_mfma_f32_32x32x16_bf16(kc[1][1], qr[3], c1, 0, 0, 0);
    SBAR();
    if constexpr (DO_PV) { WAITL(14); SBAR(); MMO(o[0], po0, a0, a1); TR2(a, 2, 0, 1); } SBAR();
    if constexpr (DO_PV) { WAITL(14); SBAR(); MMO(o[0], po1, a2, a3); TR2(a, 2, 2, 3); } SBAR();
    if constexpr (DK) __builtin_amdgcn_global_load_lds((const unsigned*)(kg + 4 * 128 + (koff ^ 32u)), (LAS unsigned*)(kd + 1024), 16, 0, 0);
    if constexpr (DO_PV) { WAITL(14); SBAR(); MMO(o[0], po2, a4, a5); TR2(a, 2, 4, 5); } SBAR();
    if constexpr (DO_PV) { WAITL(14); SBAR(); MMO(o[0], po3, a6, a7); TR2(a, 2, 6, 7); } SBAR();
    if constexpr (DO_PV) { WAITL(14); SBAR(); MMO(o[1], po0, b0, b1); TR2(b, 3, 0, 1); }
    if constexpr (DO_SM) { EX(c0, 0); EX(c0, 1); EX(c0, 2); } SBAR();
    if constexpr (DO_PV) { WAITL(14); SBAR(); MMO(o[1], po1, b2, b3); TR2(b, 3, 2, 3); }
    if constexpr (DO_SM) { EX(c0, 3); EX(c0, 4); EX(c0, 5); AD(c0, 0); AD(c0, 1); AD(c0, 2); } SBAR();
    if constexpr (DV) __builtin_amdgcn_global_load_lds((const unsigned*)(vg + voff), (LAS unsigned*)vd, 16, 0, 0);
    if constexpr (DO_PV) { WAITL(14); SBAR(); MMO(o[1], po2, b4, b5); TR2(b, 3, 4, 5); }
    if constexpr (DO_SM) { EX(c0, 6); EX(c0, 7); EX(c0, 8); AD(c0, 3); AD(c0, 4); AD(c0, 5); } SBAR();
    if constexpr (DO_PV) { WAITL(14); SBAR(); MMO(o[1], po3, b6, b7); TR2(b, 3, 6, 7); }
    if constexpr (DO_SM) { EX(c0, 9); EX(c0, 10); EX(c0, 11); AD(c0, 6); AD(c0, 7); AD(c0, 8); }
    SBAR();
    if constexpr (DO_PV) { WAITL(14); SBAR(); MMO(o[2], po0, a0, a1); }
    if constexpr (DO_SM) { EX(c0, 12); EX(c0, 13); EX(c0, 14); AD(c0, 9); AD(c0, 10); AD(c0, 11); } SBAR();
    if constexpr (DO_PV) { WAITL(12); SBAR(); MMO(o[2], po1, a2, a3); }
    if constexpr (DO_SM) { EX(c0, 15); EX(c1, 0); EX(c1, 1); AD(c0, 12); AD(c0, 13); AD(c0, 14); } SBAR();
    if constexpr (DV) __builtin_amdgcn_global_load_lds((const unsigned*)(vg + 64 + voff), (LAS unsigned*)(vd + 1024), 16, 0, 0);
    if constexpr (DO_PV) { WAITL(10); SBAR(); MMO(o[2], po2, a4, a5); }
    if constexpr (DO_SM) { EX(c1, 2); EX(c1, 3); EX(c1, 4); AD(c0, 15); AD(c1, 0); AD(c1, 1); } SBAR();
    if constexpr (DO_PV) { WAITL(8); SBAR(); MMO(o[2], po3, a6, a7); }
    if constexpr (DO_SM) { EX(c1, 5); EX(c1, 6); EX(c1, 7); AD(c1, 2); AD(c1, 3); AD(c1, 4); }
    SBAR();
    if constexpr (DO_PV) { WAITL(6); SBAR(); MMO(o[3], po0, b0, b1); }
    if constexpr (DO_QK) KLD(kf[0], 0);
    if constexpr (DO_SM) { EX(c1, 8); EX(c1, 9); EX(c1, 10); AD(c1, 5); AD(c1, 6); AD(c1, 7); CV(w0, 0, c0, 0); CV(w0, 1, c0, 2); } SBAR();
    if constexpr (DO_PV) { WAITL(4); SBAR(); MMO(o[3], po1, b2, b3); }
    if constexpr (DO_QK) KLD(kf[1], 1);
    if constexpr (DO_SM) { EX(c1, 11); EX(c1, 12); EX(c1, 13); AD(c1, 8); AD(c1, 9); AD(c1, 10); CV(w0, 2, c0, 4); CV(w0, 3, c0, 6); } SBAR();
    if constexpr (DO_PV) { WAITL(2); SBAR(); MMO(o[3], po2, b4, b5); }
    if constexpr (DO_SM) { EX(c1, 14); EX(c1, 15); AD(c1, 11); AD(c1, 12); AD(c1, 13); CV(w1, 0, c0, 8); CV(w1, 1, c0, 10); } SBAR();
    if constexpr (DO_PV) { WAITL(0); SBAR(); MMO(o[3], po3, b6, b7); }
    if constexpr (DO_SM) { AD(c1, 14); AD(c1, 15); CV(w1, 2, c0, 12); CV(w1, 3, c0, 14); } SBAR();
    if constexpr (DO_QK) {
#pragma unroll
        for (int r = 0; r < 16; ++r) { n0[r] = negm; n1[r] = negm; }
        KLD(kc[0], 2); n0 = __builtin_amdgcn_mfma_f32_32x32x16_bf16(kf[0][0], qr[0], n0, 0, 0, 0); }
    if constexpr (DO_SM) { CV(w2, 0, c1, 0); CV(w2, 1, c1, 2); } SBAR();
    if constexpr (DO_QK) { KLD(kc[1], 3); n1 = __builtin_amdgcn_mfma_f32_32x32x16_bf16(kf[0][1], qr[0], n1, 0, 0, 0); }
    if constexpr (DO_SM) { CV(w2, 2, c1, 4); CV(w2, 3, c1, 6); } SBAR();
    if constexpr (DO_QK) n0 = __builtin_amdgcn_mfma_f32_32x32x16_bf16(kf[1][0], qr[1], n0, 0, 0, 0);
    if constexpr (DO_SM) { CV(w3, 0, c1, 8); CV(w3, 1, c1, 10); } SBAR();
    if constexpr (DO_QK) n1 = __builtin_amdgcn_mfma_f32_32x32x16_bf16(kf[1][1], qr[1], n1, 0, 0, 0);
    if constexpr (DO_SM) { CV(w3, 2, c1, 12); CV(w3, 3, c1, 14); }
    if constexpr (DO_SM) { u32x4 t0 = {w0[0], w0[1], w0[2], w0[3]}, t1 = {w1[0], w1[1], w1[2], w1[3]}, t2 = {w2[0], w2[1], w2[2], w2[3]}, t3 = {w3[0], w3[1], w3[2], w3[3]};
        pn0 = *reinterpret_cast<bf16x8*>(&t0); pn1 = *reinterpret_cast<bf16x8*>(&t1); pn2 = *reinterpret_cast<bf16x8*>(&t2); pn3 = *reinterpret_cast<bf16x8*>(&t3); }
    SBAR();
}

__device__ __forceinline__ void attn_unit(const Params& p, int grp, int bh, int q0, char* lds) {
    const bf16_t* __restrict__ Qh; const bf16_t* __restrict__ Kh; const bf16_t* __restrict__ Vh; const float* __restrict__ k2;
    { const size_t ho = (size_t)bh * SEQ * 128;
      Qh = (const bf16_t*)((const unsigned char*)p.out + DO_BQ) + ho; Kh = (const bf16_t*)((const unsigned char*)p.out + DO_BK) + ho; Vh = (const bf16_t*)(p.ws + WS_BV) + ho;
      k2 = (const float*)(p.ws + WS_KMAX) + ((size_t)grp * NG * 8 + bh) * 2; }
    constexpr int LDK = 128;
    const int tid = opaque_tid(), wid = tid >> 6, lane = tid & 63, r32 = lane & 31, hi = lane >> 5, g = wid >> 2, wq = wid & 3;
    char* V_lds = lds; char* K_lds = lds + 2 * SHM_V;
    f32x16 o[4] = {}; float ls[4] = {0.f, 0.f, 0.f, 0.f}; bf16x8 qr[4];
    const bf16_t* Qw = Qh + (size_t)(q0 + wq * 32 + r32) * 128 + g * 64 + hi * 8;
#pragma unroll
    for (int d0 = 0; d0 < 4; ++d0) qr[d0] = *reinterpret_cast<const bf16x8*>(Qw + d0 * 16);
    float negm;
    { float ss = 0.f;
#pragma unroll
      for (int d0 = 0; d0 < 4; ++d0)
#pragma unroll
          for (int e = 0; e < 8; ++e) { const float q = bf2f((unsigned short)qr[d0][e]); ss = fmaf(q, q, ss); }
      auto rr = __builtin_amdgcn_permlane32_swap(__float_as_uint(ss), __float_as_uint(ss), false, false);
      ss = __uint_as_float(rr[0]) + __uint_as_float(rr[1]);
      negm = -sqrtf(ss * k2[g]); }
    const int vb0 = (int)(uintptr_t)V_lds + v_rd_base(lane);
    const int widu = __builtin_amdgcn_readfirstlane(wid);
    unsigned koff, voff;
    { const int a = widu * 2048 + lane * 16;
      const int row = a >> 8, colB = (a & 255) ^ ((row & 7) << 4); koff = (unsigned)(row * LDK + (colB >> 1));
      const int sub = a >> 9, kk = (sub >> 2) * 8 + ((a & 511) >> 6), k = kk, c = (sub & 3) * 32 + ((a & 63) >> 1); voff = (unsigned)(k * LDK + c); }
#define DMA_K(slot, k0) do { __builtin_amdgcn_global_load_lds((const unsigned*)(Kh + (size_t)(k0) * LDK + koff), (LAS unsigned*)(K_lds + (slot) * SHM_K + widu * 2048), 16, 0, 0); \
    __builtin_amdgcn_global_load_lds((const unsigned*)(Kh + (size_t)(k0) * LDK + 4 * LDK + (koff ^ 32u)), (LAS unsigned*)(K_lds + (slot) * SHM_K + widu * 2048 + 1024), 16, 0, 0); } while (0)
#define DMA_V(slot, k0) do { __builtin_amdgcn_global_load_lds((const unsigned*)(Vh + (size_t)(k0) * LDK + voff), (LAS unsigned*)(V_lds + (slot) * SHM_V + widu * 2048), 16, 0, 0); \
    __builtin_amdgcn_global_load_lds((const unsigned*)(Vh + (size_t)(k0) * LDK + 64 + voff), (LAS unsigned*)(V_lds + (slot) * SHM_V + widu * 2048 + 1024), 16, 0, 0); } while (0)
#define SWAIT() asm volatile("s_waitcnt vmcnt(0)" ::: "memory")
    f32x16 sA0, sA1, sB0, sB1; bf16x8 pX0, pX1, pX2, pX3, pY0, pY1, pY2, pY3; constexpr int NT = SEQ / KVBLK;
#define STEP(QT, QK, SM, PV, DK, DV, KT, VT, VS, KS, C0, C1, N0, N1, PO, PN) step3<QT, QK, SM, PV, DK, DV>(kc, Kh + (size_t)(KT) * (KVBLK * LDK), Vh + (size_t)(VT) * (KVBLK * LDK), \
        K_lds + ((KT) & 1) * SHM_K + widu * 2048, V_lds + ((VT) & 1) * SHM_V + widu * 2048, koff, voff, o, ls, vb0 + (VS) * SHM_V, K_lds + (KS) * SHM_K, qr, negm, g, r32, hi, C0, C1, N0, N1, PO##0, PO##1, PO##2, PO##3, PN##0, PN##1, PN##2, PN##3)
    bf16x8 kc[2][2];
    DMA_K(0, 0); DMA_K(1, KVBLK); DMA_V(0, 0); SWAIT(); __syncthreads();
    STEP(false, true, false, false, false, false, 0, 0, 0, 0, sB0, sB1, sA0, sA1, pY, pX);
    __syncthreads();
    DMA_K(0, 2 * KVBLK);
    STEP(true, true, true, false, false, false, 0, 0, 0, 1, sA0, sA1, sB0, sB1, pY, pX);
    SWAIT(); __syncthreads();
    for (int n = 1; n + 1 < NT; n += 2) {
        STEP(true, true, true, true, true, true, n + 2, n, 0, 0, sB0, sB1, sA0, sA1, pX, pY);
        SWAIT(); __syncthreads();
        const int kt = n + 3 < NT ? n + 3 : NT - 2;
        STEP(true, true, true, true, true, true, kt, n + 1, 1, 1, sA0, sA1, sB0, sB1, pY, pX);
        SWAIT(); __syncthreads();
    }
    STEP(true, false, true, true, false, true, 0, NT - 1, 0, 0, sB0, sB1, sA0, sA1, pX, pY);
    SWAIT(); __syncthreads();
    STEP(false, false, false, true, false, false, 0, 0, 1, 0, sA0, sA1, sB0, sB1, pY, pX);
    int bh2 = bh; asm volatile("" : "+s"(bh2));
    const bf16_t* __restrict__ Zh = (const bf16_t*)(p.ws + WS_SBZ) + (size_t)bh2 * SEQ * 128;
    bf16_t* __restrict__ Yrow0 = (bf16_t*)(p.ws + WS_YB) + (size_t)(bh2 >> 3) * SEQ * 1024 + (bh2 & 7) * 128;
    const float* __restrict__ subg = p.da_subln_g; const float* __restrict__ lamp = (const float*)(p.ws + WS_MISC);
    float rli[16];
    { float lt = (ls[0] + ls[1]) + (ls[2] + ls[3]);
      auto rr = __builtin_amdgcn_permlane32_swap(__float_as_uint(lt), __float_as_uint(lt), false, false);
      lt = __builtin_amdgcn_rcpf(__uint_as_float(rr[0]) + __uint_as_float(rr[1]));
#pragma unroll
      for (int r = 0; r < 16; ++r) rli[r] = __uint_as_float((unsigned)__builtin_amdgcn_ds_bpermute(crow(r, hi) * 4, (int)__float_as_uint(lt))); }
    __syncthreads();
    float* X = (float*)lds;
    if (g == 1) {
        const float lam = *lamp;
#pragma unroll
        for (int d0 = 0; d0 < 4; ++d0)
#pragma unroll
            for (int r = 0; r < 16; ++r) X[((wq * 4 + d0) * 16 + r) * 64 + lane] = o[d0][r] * rli[r] * lam;
    }
    __syncthreads();
    if (g == 0) {
        float ss[16];
#pragma unroll
        for (int r = 0; r < 16; ++r) { float a = 0.f;
#pragma unroll
            for (int d0 = 0; d0 < 4; ++d0) { const float v = o[d0][r] * rli[r] - X[((wq * 4 + d0) * 16 + r) * 64 + lane]; o[d0][r] = v; a += v * v; }
            ss[r] = a; }
#pragma unroll
        for (int r = 0; r < 16; ++r) {
#pragma unroll
            for (int off = 1; off < 32; off <<= 1) ss[r] += SHX(ss[r], off);
        }
        float sg[4];
#pragma unroll
        for (int d0 = 0; d0 < 4; ++d0) sg[d0] = subg[32 * d0 + r32] * 0.8f;
        float* Yt = (float*)(lds + 69632);
#pragma unroll
        for (int r = 0; r < 16; ++r) {
            const float rs = rsqrtf(ss[r] * (1.f / 128.f) + 1e-6f);
            const int lrow = wq * 32 + crow(r, hi);
#pragma unroll
            for (int d0 = 0; d0 < 4; ++d0) Yt[lrow * 128 + 32 * d0 + r32] = o[d0][r] * rs * sg[d0];
        }
    }
    __syncthreads();
    {
        const float* Yt = (const float*)(lds + 69632);
        const int tid3 = opaque_tid();
#pragma unroll
        for (int i = 0; i < 4; ++i) {
            const int e = tid3 + 512 * i, lrow = e >> 4, c8 = (e & 15) * 8;
            const size_t qrow = (size_t)(q0 + lrow);
            const bf16x8 z = *(const bf16x8*)(Zh + qrow * 128 + c8);
            const f32x4 y0 = *(const f32x4*)(Yt + lrow * 128 + c8), y1 = *(const f32x4*)(Yt + lrow * 128 + c8 + 4);
            u32x4 pk;
            pk.x = pg8::cvt_pk_bf16(y0[0] * bf2f((unsigned short)z[0]), y0[1] * bf2f((unsigned short)z[1])); pk.y = pg8::cvt_pk_bf16(y0[2] * bf2f((unsigned short)z[2]), y0[3] * bf2f((unsigned short)z[3]));
            pk.z = pg8::cvt_pk_bf16(y1[0] * bf2f((unsigned short)z[4]), y1[1] * bf2f((unsigned short)z[5])); pk.w = pg8::cvt_pk_bf16(y1[2] * bf2f((unsigned short)z[6]), y1[3] * bf2f((unsigned short)z[7]));
            *(u32x4*)(Yrow0 + qrow * 1024 + c8) = pk;
        }
    }
    __syncthreads();
#undef DMA_K
#undef DMA_V
#undef SWAIT
#undef STEP
}
}

__device__ __forceinline__ void phase_attention(const Params& p, char* lds, int grp) {
    const int G = gridDim.x, vcu = vcu_of(blockIdx.x, G);
    for (int it = vcu; it < NG * 8 * 64; it += G) att::attn_unit(p, grp, it >> 6, (it & 63) * 128, lds);
}

namespace ml {
constexpr int GT_A = 0, GT_B = 1, GT_MR = 2;
constexpr int GC_BLAST = 0, GC_AMAX = 1, GC_MST = 2, GC_DECAY = 3, GC_GAIN = 4;
__device__ __forceinline__ float* gtok(unsigned char* ws, int gch, int row) { return (float*)(ws + WS_GTOK) + ((size_t)gch * 3 + row) * SEQ; }
__device__ __forceinline__ float* gch_(unsigned char* ws, int gch, int row) { return (float*)(ws + WS_GCH) + ((size_t)gch * 8 + row) * NCH; }
constexpr float ST_SC = 16.f, ST_ISC = 0.0625f, ST_MAX = 448.f;
__device__ __forceinline__ unsigned char* state_ptr(const Params& p, int grp, int ch, int c) {
    const int bl = ch >> 3, dir = (ch >> 2) & 1, h = ch & 3, li = bl * 4 + h;
    unsigned char* base = dir ? p.ws + WS_HBF + (size_t)grp * TG * DM * 2 : p.ws + WS_STF;
    return base + ((size_t)li * NCH + c) * 65536;
}
__device__ __forceinline__ float st_clamp(float x) { return fminf(fmaxf(x * ST_SC, -ST_MAX), ST_MAX); }
__device__ __forceinline__ unsigned st_pack4(float a, float b, float c, float d) {
    int w = __builtin_amdgcn_cvt_pk_fp8_f32(st_clamp(a), st_clamp(b), 0, false);
    w = __builtin_amdgcn_cvt_pk_fp8_f32(st_clamp(c), st_clamp(d), w, true);
    return (unsigned)w;
}
__device__ __forceinline__ float* nstate_ptr(const Params& p, int gch, int c) { return (float*)(p.ws + WS_NST) + ((size_t)gch * NCH + c) * 256; }

__device__ __forceinline__ void phase_gateprep(const Params& p, int grp) {
    const int tid = opaque_tid(), lane = tid & 63, wave = tid >> 6;
    for (int it = blockIdx.x * NWAVES + wave; it < NG * 8 * NCH; it += gridDim.x * NWAVES) {
        const int ch = it >> 6, c = it & 63;
        const int bl = ch >> 3, dir = (ch >> 2) & 1, h = ch & 3, gch = grp * NG * 8 + ch, b = grp * NG + bl;
        const float* gates = (const float*)(p.ws + WS_GATE) + (size_t)b * SEQ * 16;
        const int ci = (2 * dir) * 4 + h, cf = (2 * dir + 1) * 4 + h;
        const float bi = p.ml_gate_b[ci], bf = p.ml_gate_b[cf];
        float* A = gtok(p.ws, gch, GT_A); float* B = gtok(p.ws, gch, GT_B); float* MR = gtok(p.ws, gch, GT_MR);
        float iv[2], lf[2];
#pragma unroll
        for (int q = 0; q < 2; ++q) {
            const int pp = c * CH + 2 * lane + q, s = dir ? SEQ - 1 - pp : pp;
            iv[q] = gates[(size_t)s * 16 + ci] + bi;
            const float f = gates[(size_t)s * 16 + cf] + bf;
            lf[q] = fminf(f, 0.f) - log1pf(expf(-fabsf(f)));
        }
        float tot = lf[0] + lf[1], inc = tot;
#pragma unroll
        for (int off = 1; off < 64; off <<= 1) { const float v = SHUP(inc, off); if (lane >= off) inc += v; }
        const float ex = inc - tot;
        const float b0 = ex + lf[0], b1 = ex + lf[0] + lf[1];
        const float a0 = iv[0] - b0, a1 = iv[1] - b1;
        float mx = fmaxf(a0, a1), minc = mx;
#pragma unroll
        for (int off = 1; off < 64; off <<= 1) { const float v = SHUP(minc, off); if (lane >= off) minc = fmaxf(minc, v); }
        float mex = SHUP(minc, 1); if (lane == 0) mex = -INFINITY;
        const float pm0 = fmaxf(mex, a0), pm1 = fmaxf(pm0, a1);
        const int p0 = c * CH + 2 * lane;
        A[p0] = a0; A[p0 + 1] = a1; B[p0] = b0; B[p0 + 1] = b1; MR[p0] = b0 + pm0; MR[p0 + 1] = b1 + pm1;
        if (lane == 63) { gch_(p.ws, gch, GC_BLAST)[c] = b1; gch_(p.ws, gch, GC_AMAX)[c] = pm1; }
    }
}
__device__ __forceinline__ void phase_gatescan(const Params& p, LAS unsigned char* lds, int grp) {
    const int tid = opaque_tid();
    LAS float* sb = (LAS float*)lds;
    for (int ch = blockIdx.x; ch < NG * 8; ch += gridDim.x) {
        const int gch = grp * NG * 8 + ch;
        if (tid < NCH) { sb[tid] = gch_(p.ws, gch, GC_BLAST)[tid]; sb[NCH + tid] = gch_(p.ws, gch, GC_AMAX)[tid]; }
        __syncthreads();
        if (tid == 0) {
            float* MS = gch_(p.ws, gch, GC_MST); float* DE = gch_(p.ws, gch, GC_DECAY); float* GA = gch_(p.ws, gch, GC_GAIN);
            float mprev = 0.f;
            for (int c = 0; c < NCH; ++c) {
                const float bl_ = sb[c], am = sb[NCH + c], mloc = bl_ + am, mnew = fmaxf(bl_ + mprev, mloc);
                MS[c] = mprev; DE[c] = expf(bl_ + mprev - mnew); GA[c] = expf(mloc - mnew);
                mprev = mnew;
            }
        }
        __syncthreads();
    }
}

constexpr int TS = 528;
constexpr int TILE_B = 128 * TS;
constexpr int PS = 272;
constexpr int CS_ = 144, CBUF = 256 * CS_;
constexpr int R0 = 0, R1 = TILE_B, R1_B = 2 * CBUF;
constexpr int SC0 = R1 + R1_B;
static_assert(SC0 + 3328 * 4 <= LDS_BYTES, "mLSTM LDS map");

__device__ __forceinline__ void stage_conv(const bf16_t* __restrict__ src, int s0, const float* __restrict__ cw  ,
                                           float scale, LAS unsigned char* dst) {
    const int tid = opaque_tid(), cg = tid & 31, rg = tid >> 5;
    float w[5][8];
#pragma unroll
    for (int j = 0; j < 5; ++j) { const f32x4 w0 = *(const f32x4*)(cw + j * 2048 + cg * 8), w1 = *(const f32x4*)(cw + j * 2048 + cg * 8 + 4);
        w[j][0] = w0[0]; w[j][1] = w0[1]; w[j][2] = w0[2]; w[j][3] = w0[3]; w[j][4] = w1[0]; w[j][5] = w1[1]; w[j][6] = w1[2]; w[j][7] = w1[3]; }
    const bf16x8 zero8 = {0, 0, 0, 0, 0, 0, 0, 0};
    const int sb = s0 + rg * 8 - 2;
    bf16x8 in[12];
#pragma unroll
    for (int i = 0; i < 12; ++i) { const int s = sb + i; in[i] = (s >= 0 && s < SEQ) ? *(const bf16x8*)(src + (size_t)s * 256 + cg * 8) : zero8; }
#pragma unroll
    for (int r = 0; r < 8; ++r) {
        float o[8];
#pragma unroll
        for (int e = 0; e < 8; ++e) {
            float a = w[0][e] * bf2f((unsigned short)in[r][e]);
            a = fmaf(w[1][e], bf2f((unsigned short)in[r + 1][e]), a); a = fmaf(w[2][e], bf2f((unsigned short)in[r + 2][e]), a);
            a = fmaf(w[3][e], bf2f((unsigned short)in[r + 3][e]), a); a = fmaf(w[4][e], bf2f((unsigned short)in[r + 4][e]), a);
            o[e] = fast_silu(a) * scale; }
        u32x4 pk; pk.x = pg8::cvt_pk_bf16(o[0], o[1]); pk.y = pg8::cvt_pk_bf16(o[2], o[3]); pk.z = pg8::cvt_pk_bf16(o[4], o[5]); pk.w = pg8::cvt_pk_bf16(o[6], o[7]);
        *(LAS u32x4*)(dst + (rg * 8 + r) * TS + cg * 16) = pk;
    }
}
__device__ __forceinline__ void stage_rows(const bf16_t* __restrict__ src, int s0, const LAS float* wrow, LAS unsigned char* dst) {
    const int tid = opaque_tid(), cg = tid & 31, rg = tid >> 5;
#pragma unroll
    for (int r = 0; r < 8; ++r) {
        const int row = rg * 8 + r;
        bf16x8 v = *(const bf16x8*)(src + (size_t)(s0 + row) * 256 + cg * 8);
        if (wrow) { const float w = wrow[row]; u32x4 pk;
            pk.x = pg8::cvt_pk_bf16(bf2f((unsigned short)v[0]) * w, bf2f((unsigned short)v[1]) * w); pk.y = pg8::cvt_pk_bf16(bf2f((unsigned short)v[2]) * w, bf2f((unsigned short)v[3]) * w);
            pk.z = pg8::cvt_pk_bf16(bf2f((unsigned short)v[4]) * w, bf2f((unsigned short)v[5]) * w); pk.w = pg8::cvt_pk_bf16(bf2f((unsigned short)v[6]) * w, bf2f((unsigned short)v[7]) * w);
            *(LAS u32x4*)(dst + row * TS + cg * 16) = pk; }
        else *(LAS bf16x8*)(dst + row * TS + cg * 16) = v;
    }
}
__device__ __forceinline__ bf16x8 frag_tr(const LAS unsigned char* tile, int stride, int k0, int n0, int lane) {
    const int g = lane >> 4, i = lane & 15, q = i >> 2, pp = i & 3;
    const LAS unsigned char* a = tile + (k0 + 8 * g + q) * stride + (n0 + 4 * pp) * 2;
    typedef short v4i16_t __attribute__((ext_vector_type(4)));
    const s16x4 lo = __builtin_bit_cast(s16x4, __builtin_amdgcn_ds_read_tr16_b64_v4i16((LAS v4i16_t*)a));
    const s16x4 hi = __builtin_bit_cast(s16x4, __builtin_amdgcn_ds_read_tr16_b64_v4i16((LAS v4i16_t*)(a + 4 * stride)));
    return (bf16x8){lo[0], lo[1], lo[2], lo[3], hi[0], hi[1], hi[2], hi[3]};
}
__device__ __forceinline__ bf16x8 frag_row(const LAS unsigned char* tile, int stride, int n0, int k0, int lane) {
    return *(const LAS bf16x8*)(tile + (n0 + (lane & 15)) * stride + (k0 + 8 * (lane >> 4)) * 2);
}

__device__ __forceinline__ void mlocal_item(const Params& p, LAS unsigned char* lds, int grp, int ch, int c) {
    int tid_ = threadIdx.x; asm volatile("" : "+v"(tid_));
    const int tid = tid_, lane = tid & 63, wave = tid >> 6, wr = wave >> 2, wc = wave & 3;
    const int bl = ch >> 3, dir = (ch >> 2) & 1, h = ch & 3, gch = grp * NG * 8 + ch;
    const int oc = dir ? NCH - 1 - c : c, s0 = oc * CH;
    LAS float* wrow = (LAS float*)(lds + SC0);
    __syncthreads();
    if (tid < CH) { const int j = dir ? CH - 1 - tid : tid;
        wrow[tid] = fast_exp(gtok(p.ws, gch, GT_A)[c * CH + j] - gch_(p.ws, gch, GC_AMAX)[c]); }
    const bf16_t* AKh = (const bf16_t*)(p.ws + WS_AK) + (size_t)(bl * 4 + h) * SEQ * 256;
    const bf16_t* AVh = (const bf16_t*)(p.ws + WS_AV) + (size_t)(bl * 4 + h) * SEQ * 256;
    bf16x8 vpre[8];
    { const int cg = tid & 31, rg = tid >> 5;
#pragma unroll
      for (int r = 0; r < 8; ++r) vpre[r] = *(const bf16x8*)(AVh + (size_t)(s0 + rg * 8 + r) * 256 + cg * 8); }
    stage_conv(AKh, s0, p.ml_conv_w + 1024 + h * 256, 0.0625f, lds + R1);
    __syncthreads();
    { const int cg = tid & 31, rg = tid >> 5;
#pragma unroll
      for (int r = 0; r < 8; ++r) { const int row = rg * 8 + r; const float w = wrow[row]; const bf16x8 v = vpre[r]; u32x4 pk;
        pk.x = pg8::cvt_pk_bf16(bf2f((unsigned short)v[0]) * w, bf2f((unsigned short)v[1]) * w); pk.y = pg8::cvt_pk_bf16(bf2f((unsigned short)v[2]) * w, bf2f((unsigned short)v[3]) * w);
        pk.z = pg8::cvt_pk_bf16(bf2f((unsigned short)v[4]) * w, bf2f((unsigned short)v[5]) * w); pk.w = pg8::cvt_pk_bf16(bf2f((unsigned short)v[6]) * w, bf2f((unsigned short)v[7]) * w);
        *(LAS u32x4*)(lds + R0 + row * TS + cg * 16) = pk; } }
    __syncthreads();
    if (tid < 256) { float a0 = 0.f, a1 = 0.f, a2 = 0.f, a3 = 0.f;
#pragma unroll 2
        for (int s = 0; s < CH; s += 8) {
            float kv[8];
#pragma unroll
            for (int u = 0; u < 8; ++u) kv[u] = bf2f(*(const LAS unsigned short*)(lds + R1 + (s + u) * TS + tid * 2));
            const f32x4 w0 = *(const LAS f32x4*)(wrow + s), w1 = *(const LAS f32x4*)(wrow + s + 4);
            a0 = fmaf(w0[0], kv[0], a0); a1 = fmaf(w0[1], kv[1], a1); a2 = fmaf(w0[2], kv[2], a2); a3 = fmaf(w0[3], kv[3], a3);
            a0 = fmaf(w1[0], kv[4], a0); a1 = fmaf(w1[1], kv[5], a1); a2 = fmaf(w1[2], kv[6], a2); a3 = fmaf(w1[3], kv[7], a3);
        }
        nstate_ptr(p, gch, c)[tid] = (a0 + a1) + (a2 + a3); }
    f32x4 acc[8][4];
#pragma unroll
    for (int i = 0; i < 8; ++i)
#pragma unroll
        for (int j = 0; j < 4; ++j) acc[i][j] = (f32x4){0.f, 0.f, 0.f, 0.f};
#pragma unroll 1
    for (int ks = 0; ks < 4; ++ks) {
        bf16x8 bfr[4];
#pragma unroll
        for (int j = 0; j < 4; ++j) bfr[j] = frag_tr(lds + R0, TS, ks * 32, wc * 64 + j * 16, lane);
#pragma unroll
        for (int i = 0; i < 8; ++i) { const bf16x8 afr = frag_tr(lds + R1, TS, ks * 32, wr * 128 + i * 16, lane);
#pragma unroll
            for (int j = 0; j < 4; ++j) acc[i][j] = __builtin_amdgcn_mfma_f32_16x16x32_bf16(afr, bfr[j], acc[i][j], 0, 0, 0); }
    }
    __syncthreads();
    const int fr = lane & 15, fq = lane >> 4;
#pragma unroll
    for (int i = 0; i < 8; ++i)
#pragma unroll
        for (int j = 0; j < 4; ++j) { const int dv = wc * 64 + j * 16 + fr, dk = wr * 128 + i * 16 + 4 * fq;
            *(LAS unsigned*)(lds + dv * 272 + dk) = st_pack4(acc[i][j][0], acc[i][j][1], acc[i][j][2], acc[i][j][3]); }
    __syncthreads();
    unsigned char* C = state_ptr(p, grp, ch, c);
#pragma unroll
    for (int i = 0; i < 8; ++i) { const int e = tid + 512 * i, row = e >> 4, c16 = e & 15;
        *(u32x4*)(C + (size_t)row * 256 + c16 * 16) = *(const LAS u32x4*)(lds + row * 272 + c16 * 16); }
}
__device__ __forceinline__ void phase_mlocal(const Params& p, LAS unsigned char* lds, int grp) {
    for (int it = blockIdx.x; it < NG * 8 * NCH; it += gridDim.x) mlocal_item(p, lds, grp, it >> 6, it & 63);
}

__device__ __forceinline__ void phase_mscan(const Params& p, int grp) {
    const int gt = blockIdx.x * NTHR + opaque_tid(), NT = gridDim.x * NTHR;
    for (int v = gt; v < NG * 8 * 8192; v += NT) {
        const int ch = v >> 13, vec = v & 8191, gch = grp * NG * 8 + ch;
        const float* DE = gch_(p.ws, gch, GC_DECAY); const float* GA = gch_(p.ws, gch, GC_GAIN);
        unsigned char* base = state_ptr(p, grp, ch, 0) + (size_t)vec * 8;
        float acc[8];
#pragma unroll
        for (int e = 0; e < 8; ++e) acc[e] = 0.f;
        for (int c0 = 0; c0 < NCH; c0 += 4) {
            u32x2 d[4];
#pragma unroll
            for (int u = 0; u < 4; ++u) d[u] = *(const u32x2*)(base + (size_t)(c0 + u) * 65536);
#pragma unroll
            for (int u = 0; u < 4; ++u) {
                const float de = DE[c0 + u], ga = GA[c0 + u] * ST_ISC;
                u32x2 pk; pk.x = st_pack4(acc[0], acc[1], acc[2], acc[3]); pk.y = st_pack4(acc[4], acc[5], acc[6], acc[7]);
                *(u32x2*)(base + (size_t)(c0 + u) * 65536) = pk;
                const auto f0 = __builtin_amdgcn_cvt_pk_f32_fp8((int)d[u].x, false), f1 = __builtin_amdgcn_cvt_pk_f32_fp8((int)d[u].x, true);
                const auto f2 = __builtin_amdgcn_cvt_pk_f32_fp8((int)d[u].y, false), f3 = __builtin_amdgcn_cvt_pk_f32_fp8((int)d[u].y, true);
                acc[0] = de * acc[0] + ga * f0[0]; acc[1] = de * acc[1] + ga * f0[1]; acc[2] = de * acc[2] + ga * f1[0]; acc[3] = de * acc[3] + ga * f1[1];
                acc[4] = de * acc[4] + ga * f2[0]; acc[5] = de * acc[5] + ga * f2[1]; acc[6] = de * acc[6] + ga * f3[0]; acc[7] = de * acc[7] + ga * f3[1];
            }
        }
    }
    for (int v = gt; v < NG * 8 * 256; v += NT) {
        const int ch = v >> 8, dk = v & 255, gch = grp * NG * 8 + ch;
        const float* DE = gch_(p.ws, gch, GC_DECAY); const float* GA = gch_(p.ws, gch, GC_GAIN);
        float acc = 0.f;
        for (int c = 0; c < NCH; ++c) { float* q = nstate_ptr(p, gch, c) + dk; const float d = *q; *q = acc; acc = DE[c] * acc + GA[c] * d; }
    }
}

__device__ __forceinline__ void mout_item(const Params& p, LAS unsigned char* lds, int grp, int bl, int h, int oc) {
    int tid_ = threadIdx.x; asm volatile("" : "+v"(tid_));
    const int tid = tid_, lane = tid & 63, wave = tid >> 6, wr = wave >> 2, wc = wave & 3, fr = lane & 15, fq = lane >> 4;
    const int s0 = oc * CH, chf = (bl * 2 + 0) * 4 + h, chb = (bl * 2 + 1) * 4 + h, gf = grp * NG * 8 + chf, gb = grp * NG * 8 + chb, cb = NCH - 1 - oc;
    LAS float* SC = (LAS float*)(lds + SC0);
    LAS float* RT = SC;
    LAS float* SI = SC + 256;
    LAS float* EM = SC + 512;
    LAS float* AS = SC + 768;
    LAS float* NS = SC + 1024;
    LAS float* DENP = SC + 1536;
    LAS float* DENI = SC + 2560;
    LAS float* SS = SC + 2816;
    __syncthreads();
    if (tid < 256) {
        const int d = tid >> 7, t = tid & 127, g = d ? gb : gf, c = d ? cb : oc, pp = c * CH + (d ? CH - 1 - t : t);
        const float b = gtok(p.ws, g, GT_B)[pp], mr = gtok(p.ws, g, GT_MR)[pp], a = gtok(p.ws, g, GT_A)[pp], ms = gch_(p.ws, g, GC_MST)[c];
        const float m = fmaxf(b + ms, mr);
        RT[tid] = b - m; SI[tid] = fast_exp(b + ms - m); EM[tid] = fast_exp(-m); AS[tid] = a;
    } else {
        const int d = (tid - 256) >> 7, k2 = (tid - 256) & 127;
        const float* n = nstate_ptr(p, d ? gb : gf, d ? cb : oc);
        NS[d * 256 + 2 * k2] = n[2 * k2]; NS[d * 256 + 2 * k2 + 1] = n[2 * k2 + 1];
    }
    const bf16_t* AQh = (const bf16_t*)(p.ws + WS_AQ) + (size_t)(bl * 4 + h) * SEQ * 256;
    const bf16_t* AKh = (const bf16_t*)(p.ws + WS_AK) + (size_t)(bl * 4 + h) * SEQ * 256;
    const bf16_t* AVh = (const bf16_t*)(p.ws + WS_AV) + (size_t)(bl * 4 + h) * SEQ * 256;
    stage_conv(AQh, s0, p.ml_conv_w + h * 256, 1.f, lds + R0);
    asm volatile("" ::: "memory");
    stage_conv(AKh, s0, p.ml_conv_w + 1024 + h * 256, 0.0625f, lds + R1);
    __syncthreads();
    f32x4 sacc[2][4];
#pragma unroll
    for (int i = 0; i < 2; ++i)
#pragma unroll
        for (int j = 0; j < 4; ++j) sacc[i][j] = (f32x4){0.f, 0.f, 0.f, 0.f};
#pragma unroll
    for (int ks = 0; ks < 8; ++ks) {
        bf16x8 qf[4];
#pragma unroll
        for (int j = 0; j < 4; ++j) qf[j] = frag_row(lds + R0, TS, wr * 64 + j * 16, ks * 32, lane);
#pragma unroll
        for (int i = 0; i < 2; ++i) { const bf16x8 kf = frag_row(lds + R1, TS, wc * 32 + i * 16, ks * 32, lane);
#pragma unroll
            for (int j = 0; j < 4; ++j) sacc[i][j] = __builtin_amdgcn_mfma_f32_16x16x32_bf16(kf, qf[j], sacc[i][j], 0, 0, 0); }
    }
    {
        const int t = tid >> 2, qd = tid & 3; float df = 0.f, db = 0.f;
#pragma unroll
        for (int e8 = 0; e8 < 8; ++e8) { const bf16x8 qv = *(const LAS bf16x8*)(lds + R0 + t * TS + (qd * 64 + e8 * 8) * 2);
#pragma unroll
            for (int e = 0; e < 8; ++e) { const float q = bf2f((unsigned short)qv[e]); df = fmaf(q, NS[qd * 64 + e8 * 8 + e], df); db = fmaf(q, NS[256 + qd * 64 + e8 * 8 + e], db); } }
        df += SHX(df, 1); df += SHX(df, 2); db += SHX(db, 1); db += SHX(db, 2);
        if (qd == 0) { DENI[t] = df; DENI[128 + t] = db; }
    }
    __syncthreads();
    f32x4 acc[2][4][4];
    {
        const int e0 = tid;
        u32x4 cst[2];
#define C_SRC(s_) (state_ptr(p, grp, (s_) >= 4 ? chb : chf, (s_) >= 4 ? cb : oc) + ((s_) & 3) * 64)
#define C_LOAD(s_) do { const unsigned char* cs_ = C_SRC(s_); _Pragma("unroll") for (int i = 0; i < 2; ++i) { const int e = e0 + 512 * i; cst[i] = *(const u32x4*)(cs_ + (size_t)(e >> 2) * 256 + (e & 3) * 16); } } while (0)
#define C_CVT2(w_, lo_, hi_) do { const auto f0_ = __builtin_amdgcn_cvt_pk_f32_fp8((int)(w_), false), f1_ = __builtin_amdgcn_cvt_pk_f32_fp8((int)(w_), true); \
        lo_ = pg8::cvt_pk_bf16(f0_[0] * ST_ISC, f0_[1] * ST_ISC); hi_ = pg8::cvt_pk_bf16(f1_[0] * ST_ISC, f1_[1] * ST_ISC); } while (0)
#define C_WRITE(b_) do { _Pragma("unroll") for (int i = 0; i < 2; ++i) { const int e = e0 + 512 * i; u32x4 lo4, hi4; \
        C_CVT2(cst[i].x, lo4.x, lo4.y); C_CVT2(cst[i].y, lo4.z, lo4.w); C_CVT2(cst[i].z, hi4.x, hi4.y); C_CVT2(cst[i].w, hi4.z, hi4.w); \
        LAS unsigned char* d_ = lds + R1 + (b_) * CBUF + (e >> 2) * CS_ + (e & 3) * 32; *(LAS u32x4*)d_ = lo4; *(LAS u32x4*)(d_ + 16) = hi4; } } while (0)
        C_LOAD(0); C_WRITE(0);
        __syncthreads();
#pragma unroll
        for (int d = 0; d < 2; ++d) {
#pragma unroll
            for (int i = 0; i < 4; ++i)
#pragma unroll
                for (int j = 0; j < 4; ++j) acc[d][i][j] = (f32x4){0.f, 0.f, 0.f, 0.f};
#pragma unroll 1
            for (int q = 0; q < 4; ++q) {
                const int st = d * 4 + q;
                if (st < 7) C_LOAD(st + 1);
                const LAS unsigned char* cb_ = lds + R1 + (q & 1) * CBUF;
#pragma unroll
                for (int k2 = 0; k2 < 2; ++k2) {
                    bf16x8 cf[4], qf[4];
#pragma unroll
                    for (int i = 0; i < 4; ++i) cf[i] = frag_row(cb_, CS_, wc * 64 + i * 16, k2 * 32, lane);
#pragma unroll
                    for (int j = 0; j < 4; ++j) qf[j] = frag_row(lds + R0, TS, wr * 64 + j * 16, q * 64 + k2 * 32, lane);
#pragma unroll
                    for (int i = 0; i < 4; ++i)
#pragma unroll
                        for (int j = 0; j < 4; ++j) acc[d][i][j] = __builtin_amdgcn_mfma_f32_16x16x32_bf16(cf[i], qf[j], acc[d][i][j], 0, 0, 0);
                }
                if (st < 7) C_WRITE((q + 1) & 1);
                __syncthreads();
            }
#pragma unroll
            for (int j = 0; j < 4; ++j) { const float si = SI[d * 128 + wr * 64 + j * 16 + fr];
#pragma unroll
                for (int i = 0; i < 4; ++i) acc[d][i][j] = acc[d][i][j] * si; }
        }
#undef C_SRC
#undef C_LOAD
#undef C_CVT2
#undef C_WRITE
    }
    {
        LAS unsigned char* Pf = lds + R1; LAS unsigned char* Pb = lds + R1 + 128 * PS;
#pragma unroll
        for (int j = 0; j < 4; ++j) {
            const int t = wr * 64 + j * 16 + fr;
            const float rtf = RT[t], rtb = RT[128 + t];
            float sf = 0.f, sbw = 0.f;
#pragma unroll
            for (int i = 0; i < 2; ++i) {
                const int sb0 = wc * 32 + i * 16 + 4 * fq;
                float pf[4], pb[4];
#pragma unroll
                for (int r = 0; r < 4; ++r) { const int s = sb0 + r; const float sv = sacc[i][j][r];
                    pf[r] = (s <= t) ? sv * fast_exp(rtf + AS[s]) : 0.f;
                    pb[r] = (s >= t) ? sv * fast_exp(rtb + AS[128 + s]) : 0.f;
                    sf += pf[r]; sbw += pb[r]; }
                u32x2 a; a.x = pg8::cvt_pk_bf16(pf[0], pf[1]); a.y = pg8::cvt_pk_bf16(pf[2], pf[3]);
                u32x2 b; b.x = pg8::cvt_pk_bf16(pb[0], pb[1]); b.y = pg8::cvt_pk_bf16(pb[2], pb[3]);
                *(LAS u32x2*)(Pf + t * PS + sb0 * 2) = a; *(LAS u32x2*)(Pb + t * PS + sb0 * 2) = b;
            }
            sf += SHX(sf, 16); sf += SHX(sf, 32); sbw += SHX(sbw, 16); sbw += SHX(sbw, 32);
            if (fq == 0) { DENP[(0 * 4 + wc) * 128 + t] = sf; DENP[(1 * 4 + wc) * 128 + t] = sbw; }
        }
    }
    __syncthreads();
    stage_rows(AVh, s0, (const LAS float*)nullptr, lds + R0);
    __syncthreads();
#pragma unroll 1
    for (int ks = 0; ks < 4; ++ks) {
        bf16x8 vf[4];
#pragma unroll
        for (int i = 0; i < 4; ++i) vf[i] = frag_tr(lds + R0, TS, ks * 32, wc * 64 + i * 16, lane);
#pragma unroll
        for (int d = 0; d < 2; ++d) {
            const LAS unsigned char* P = lds + R1 + d * 128 * PS;
#pragma unroll
            for (int j = 0; j < 4; ++j) { const bf16x8 pf = frag_row(P, PS, wr * 64 + j * 16, ks * 32, lane);
#pragma unroll
                for (int i = 0; i < 4; ++i) acc[d][i][j] = __builtin_amdgcn_mfma_f32_16x16x32_bf16(vf[i], pf, acc[d][i][j], 0, 0, 0); }
        }
    }
    float ssq[4];
#pragma unroll
    for (int j = 0; j < 4; ++j) {
        const int t = wr * 64 + j * 16 + fr;
        float dn[2];
#pragma unroll
        for (int d = 0; d < 2; ++d) { const float den = (DENP[(d * 4 + 0) * 128 + t] + DENP[(d * 4 + 1) * 128 + t]) + (DENP[(d * 4 + 2) * 128 + t] + DENP[(d * 4 + 3) * 128 + t]) + SI[d * 128 + t] * DENI[d * 128 + t];
            dn[d] = __builtin_amdgcn_rcpf(fmaxf(fabsf(den), EM[d * 128 + t])); }
        float a = 0.f;
#pragma unroll
        for (int i = 0; i < 4; ++i) { const f32x4 hv = acc[0][i][j] * dn[0] + acc[1][i][j] * dn[1]; acc[0][i][j] = hv; a += (hv[0] * hv[0] + hv[1] * hv[1]) + (hv[2] * hv[2] + hv[3] * hv[3]); }
        a += SHX(a, 16); a += SHX(a, 32);
        ssq[j] = a;
        if (fq == 0) SS[wc * 128 + t] = a;
    }
    __syncthreads();
    const bf16_t* OZh = (const bf16_t*)(p.ws + WS_OZ) + ((size_t)(bl * 4 + h) * SEQ + s0) * 256;
    bf16_t* YA = (bf16_t*)(p.ws + WS_YA) + ((size_t)bl * SEQ + s0) * 1024 + h * 256;
#pragma unroll
    for (int j = 0; j < 4; ++j) {
        const int t = wr * 64 + j * 16 + fr;
        const float rs = rsqrtf(((SS[t] + SS[128 + t]) + (SS[256 + t] + SS[384 + t])) * (1.f / 256.f) + 1e-6f);
#pragma unroll
        for (int i = 0; i < 4; ++i) { const int dv = wc * 64 + i * 16 + 4 * fq;
            const f32x4 g = *(const f32x4*)(p.ml_norm_g + h * 256 + dv);
            const u32x2 oz = *(const u32x2*)(OZh + (size_t)t * 256 + dv);
            const f32x4 hv = acc[0][i][j];
            const float y0 = hv[0] * rs * g[0] * __uint_as_float(oz.x << 16), y1 = hv[1] * rs * g[1] * __uint_as_float(oz.x & 0xffff0000u);
            const float y2 = hv[2] * rs * g[2] * __uint_as_float(oz.y << 16), y3 = hv[3] * rs * g[3] * __uint_as_float(oz.y & 0xffff0000u);
            u32x2 pk; pk.x = pg8::cvt_pk_bf16(y0, y1); pk.y = pg8::cvt_pk_bf16(y2, y3);
            *(u32x2*)(YA + (size_t)t * 1024 + dv) = pk; }
        asm volatile("" ::: "memory");
    }
    (void)ssq;
}
__device__ __forceinline__ void phase_mout(const Params& p, LAS unsigned char* lds, int grp) {
    for (int it = blockIdx.x; it < NG * 4 * NCH; it += gridDim.x) mout_item(p, lds, grp, it >> 8, (it >> 6) & 3, it & 63);
}
}

__device__ __forceinline__ void phase_mix1(const Params& p, LAS unsigned char* lds, int grp) {
    pg8::Gemm g{(const bf16_t*)(p.ws + WS_YA), (const bf16_t*)(p.ws + WS_WA), TG, DM, DM};
    pg8::StaticOrder S; S.init(TG, DM, gridDim.x, (int)blockIdx.x);
    pg8::EpiMix<false> E{(const bf16_t*)(p.ws + WS_SGA), (bf16_t*)(p.ws + WS_MIX)};
    pg8::gemm_phase<pg8::EpiMix<false>, pg8::StaticOrder, true, true>(lds, g, S, E);
}
__device__ __forceinline__ void phase_mix2(const Params& p, LAS unsigned char* lds, int grp) {
    pg8::Gemm g{(const bf16_t*)(p.ws + WS_YB), (const bf16_t*)(p.ws + WS_WB), TG, DM, DM};
    pg8::StaticOrder S; S.init(TG, DM, gridDim.x, (int)blockIdx.x);
    pg8::EpiMix<true> E{(const bf16_t*)(p.ws + WS_SGB), (bf16_t*)(p.ws + WS_MIX)};
    pg8::gemm_phase<pg8::EpiMix<true>, pg8::StaticOrder, true, true>(lds, g, S, E);
}
__device__ __forceinline__ void phase_outproj(const Params& p, LAS unsigned char* lds, int grp) {
    pg8::Gemm g{(const bf16_t*)(p.ws + WS_MIX), (const bf16_t*)(p.ws + WS_WO), TG, DM, DM};
    pg8::StaticOrder S; S.init(TG, DM, gridDim.x, (int)blockIdx.x);
    pg8::EpiResid E{p.x + (size_t)grp * TG * DM, p.out + (size_t)grp * TG * DM};
    pg8::gemm_phase<pg8::EpiResid, pg8::StaticOrder, true, true>(lds, g, S, E);
}
__device__ __forceinline__ void phase_finalnorm(const Params& p, int grp) {
    const int tid = opaque_tid(), lane = tid & 63, wave = tid >> 6;
    const int gw = blockIdx.x * NWAVES + wave, NGW = gridDim.x * NWAVES;
    f32x4 vn[4];
    if (gw < TG) { const f32x4* xr0 = (const f32x4*)(p.out + ((size_t)grp * TG + gw) * DM) + lane;
#pragma unroll
        for (int j = 0; j < 4; ++j) vn[j] = xr0[64 * j]; }
    for (int m = gw; m < TG; m += NGW) {
        f32x4* xr = (f32x4*)(p.out + ((size_t)grp * TG + m) * DM) + lane;
        f32x4 v[4]; float s = 0.f;
#pragma unroll
        for (int j = 0; j < 4; ++j) { v[j] = vn[j]; s += (v[j][0] * v[j][0] + v[j][1] * v[j][1]) + (v[j][2] * v[j][2] + v[j][3] * v[j][3]); }
        if (m + NGW < TG) { const f32x4* xn = (const f32x4*)(p.out + ((size_t)grp * TG + m + NGW) * DM) + lane;
#pragma unroll
            for (int j = 0; j < 4; ++j) vn[j] = xn[64 * j]; }
        const float rstd = rsqrtf(wave_sum(s, lane) * (1.f / DM) + 1e-6f);
#pragma unroll
        for (int j = 0; j < 4; ++j) { const f32x4 g = *((const f32x4*)p.final_g + lane + 64 * j); xr[64 * j] = v[j] * rstd * g; }
    }
}
#define RLX_AGENT __ATOMIC_RELAXED, __HIP_MEMORY_SCOPE_AGENT
#define XB_TMO      128
#define XB_XCNT(j)  (256  + 64 * (j))
#define XB_XSUB(j)  (1280 + 64 * (j))
#define XB_XGEN(j)  (2304 + 64 * (j))
#define XB_TOP      3328
#define XB_TOPGEN   3392
#define XCD_BAR_WORDS 3456
#define XB_SPIN_CAP (1u << 18)

__device__ __forceinline__ unsigned xb_ld(unsigned* p)              { return __hip_atomic_load(p, __ATOMIC_RELAXED, __HIP_MEMORY_SCOPE_AGENT); }
__device__ __forceinline__ unsigned xb_add(unsigned* p, unsigned v) { return __hip_atomic_fetch_add(p, v, __ATOMIC_RELAXED, __HIP_MEMORY_SCOPE_AGENT); }
__device__ __forceinline__ unsigned xb_xcc_id() { return (unsigned)__builtin_amdgcn_s_getreg((3 << 11) | 20) & 0xFu; }
#define XB_SPIN(cond, bar) do { unsigned _sp = 0; while (cond) { __builtin_amdgcn_s_sleep(1); \
    if ((++_sp & 255u) == 0u) { if (xb_ld(&(bar)[XB_TMO])) break; if (_sp > XB_SPIN_CAP) { atomicAdd(&(bar)[XB_TMO], 1u); break; } } } } while (0)

struct XcdBarrier {
    unsigned* bar; unsigned x;
    volatile LAS unsigned* st;
};

__device__ __forceinline__ XcdBarrier xcd_barrier_post(unsigned* bar, volatile LAS unsigned* st) {
    XcdBarrier b; b.bar = bar; b.x = xb_xcc_id(); b.st = st;
    if (threadIdx.x == 0) (void)xb_add(&bar[XB_XCNT(b.x)], 1u);
    return b;
}
__device__ __forceinline__ void xcd_barrier_complete(unsigned* bar, unsigned x, unsigned& nloc, unsigned& nx) {
    const unsigned G = gridDim.x * gridDim.y * gridDim.z;
    unsigned sum, cnt, mine, sp = 0u;
    for (;;) {
        sum = 0u; cnt = 0u; mine = 0u;
#pragma unroll
        for (unsigned j = 0; j < 16; ++j) { const unsigned c = xb_ld(&bar[XB_XCNT(j)]); sum += c; cnt += (c > 0u) ? 1u : 0u; mine = (j == x) ? c : mine; }
        if (sum == G) break;
        __builtin_amdgcn_s_sleep(1);
        if ((++sp & 255u) == 0u) { if (xb_ld(&bar[XB_TMO])) break; if (sp > XB_SPIN_CAP) { atomicAdd(&bar[XB_TMO], 1u); break; } }
    }
    nloc = mine > 0u ? mine : 1u; nx = cnt > 0u ? cnt : 1u;
}

__device__ __forceinline__ void xcd_barrier(const XcdBarrier& b) {
    asm volatile("s_waitcnt vmcnt(0)" ::: "memory");
    __syncthreads();
    if (threadIdx.x == 0) {
        unsigned* bar = b.bar;
        __builtin_amdgcn_s_waitcnt(0);
        unsigned nloc = b.st[0], nx = b.st[1];
        if (nloc == 0u) { xcd_barrier_complete(bar, b.x, nloc, nx); b.st[0] = nloc; b.st[1] = nx; }
        const unsigned old = xb_add(&bar[XB_XSUB(b.x)], 1u);
        const unsigned gen = old / nloc;
        if (old + 1u == (gen + 1u) * nloc) {
            __builtin_amdgcn_fence(__ATOMIC_RELEASE, "agent");
            asm volatile("s_waitcnt vmcnt(0)" ::: "memory");
            const unsigned og = xb_add(&bar[XB_TOP], 1u);
            const unsigned tg = og / nx;
            if (og + 1u == (tg + 1u) * nx) xb_add(&bar[XB_TOPGEN], 1u);
            else XB_SPIN(xb_ld(&bar[XB_TOPGEN]) == tg, bar);
            __builtin_amdgcn_fence(__ATOMIC_ACQUIRE, "agent");
            xb_add(&bar[XB_XGEN(b.x)], 1u);
            asm volatile("s_waitcnt vmcnt(0)" ::: "memory");
        } else {
            XB_SPIN(xb_ld(&bar[XB_XGEN(b.x)]) == gen, bar);
            __builtin_amdgcn_fence(__ATOMIC_ACQUIRE, "agent");
            asm volatile("s_waitcnt vmcnt(0)" ::: "memory");
        }
    }
    __syncthreads();
}

constexpr int MISC_OFF = LDS_BYTES - 64;
__global__ void __launch_bounds__(NTHR, 2) mega_k(Params p) {
    extern __shared__ __attribute__((aligned(16))) unsigned char lds[];
    cg::grid_group grid = cg::this_grid();
    LAS unsigned char* L = (LAS unsigned char*)lds;
    volatile LAS unsigned* MISC = (volatile LAS unsigned*)(L + MISC_OFF);
    if (threadIdx.x < 16) MISC[threadIdx.x] = 0u;
    __syncthreads();
    XcdBarrier bar = xcd_barrier_post((unsigned*)(p.ws + WS_CTL) + 4096, MISC + 8);
    phase_prologue(p, L);
    grid.sync();
    for (int g = 0; g < NGRP; ++g) {
        ml::phase_gateprep(p, g);
        phase_inproj(p, L, g);
        xcd_barrier(bar);
        ml::phase_gatescan(p, L, g);
        phase_attention(p, (char*)lds, g);
        __syncthreads();
        ml::phase_mlocal(p, L, g);
        xcd_barrier(bar);
        ml::phase_mscan(p, g);
        xcd_barrier(bar);
        ml::phase_mout(p, L, g);
        xcd_barrier(bar);
        phase_mix1(p, L, g);
        __syncthreads();
        phase_mix2(p, L, g);
        xcd_barrier(bar);
        phase_outproj(p, L, g);
        xcd_barrier(bar);
        phase_finalnorm(p, g);
    }
}

extern "C" void kernel_launch(void* const* d_in, const int* in_sizes, int n_in, void* d_out, int out_size, void* d_ws, size_t ws_size, hipStream_t stream) {
    static int grid_blocks = 0;
    if (ws_size < WS_STF + GB || n_in != 14) { fprintf(stderr, "kernel_launch: needs 14 inputs and >= %zu bytes of workspace (got %d, %zu); nothing launched\n", (size_t)(WS_STF + GB), n_in, ws_size); return; }
    if (!grid_blocks) {
        int dev = 0, cus = 0, per_cu = 0;
        (void)hipGetDevice(&dev);
        (void)hipDeviceGetAttribute(&cus, hipDeviceAttributeMultiprocessorCount, dev);
        (void)hipFuncSetAttribute((const void*)mega_k, hipFuncAttributeMaxDynamicSharedMemorySize, LDS_BYTES);
        (void)hipOccupancyMaxActiveBlocksPerMultiprocessor(&per_cu, (const void*)mega_k, NTHR, LDS_BYTES);
        if (per_cu < 1) per_cu = 1;
        grid_blocks = cus * per_cu;
        if (grid_blocks > 256) grid_blocks = 256;
    }
    Params p{};
    p.x = (const float*)d_in[0]; p.pos = (const int*)d_in[1]; p.norm_g = (const float*)d_in[2]; p.w_in = (const float*)d_in[3];
    p.ml_gate_b = (const float*)d_in[4]; p.ml_conv_w = (const float*)d_in[5]; p.ml_norm_g = (const float*)d_in[6]; p.da_lambda = (const float*)d_in[7];
    p.da_subln_g = (const float*)d_in[8]; p.gate_b = (const float*)d_in[9]; p.w_a = (const float*)d_in[10]; p.w_b = (const float*)d_in[11];
    p.w_out = (const float*)d_in[12]; p.final_g = (const float*)d_in[13];
    p.out = (float*)d_out; p.ws = (unsigned char*)d_ws; p.grp = 0; p.pad = 0;
    (void)hipMemsetAsync((char*)d_ws + WS_CTL, 0, 65536, stream);
    void* args[] = {&p};
    hipError_t e = hipLaunchCooperativeKernel((const void*)mega_k, dim3(grid_blocks), dim3(NTHR), args, LDS_BYTES, stream);
    if (e != hipSuccess) fprintf(stderr, "cooperative launch failed: %s (grid %d)\n", hipGetErrorString(e), grid_blocks);
}
```

```cpp
#define MK_NG 2
#include <hip/hip_runtime.h>
#include <hip/hip_cooperative_groups.h>
#include <cstdio>
#include <cstdint>
#include <math.h>
namespace cg = cooperative_groups;

constexpr int SEQ = 8192, DM = 1024, NBATCH = 4, PW = 11280;
constexpr int TOK = NBATCH * SEQ;
#ifndef MK_NG
#define MK_NG 2
#endif
constexpr int NG = MK_NG;
constexpr int NGRP = NBATCH / NG;
constexpr int TG = NG * SEQ;
constexpr int NPROJ = 11264;
constexpr int NCH = 64, CH = 128;
constexpr int NWAVES = 8, NTHR = 512;

constexpr size_t MiB = 1u << 20;
constexpr size_t WS_CTL = 0;
constexpr size_t WS_KMAX = 32768;
constexpr size_t WS_MISC = 1 * MiB;
constexpr size_t WS_WIN = 2 * MiB;
constexpr size_t WS_WA = 24 * MiB, WS_WB = 26 * MiB, WS_WO = 28 * MiB;
constexpr size_t WS_CS = 30 * MiB;
constexpr size_t WS_GATE = 38 * MiB;
constexpr size_t WS_GTOK = 40 * MiB;
constexpr size_t WS_GCH = 44 * MiB;
constexpr size_t WS_NST = 45 * MiB;
constexpr size_t WS_HBF = 48 * MiB;
constexpr size_t GB = (size_t)NG * 16 * MiB;
constexpr size_t WS_G0 = 112 * MiB;
constexpr size_t WS_AQ = WS_G0 + 0 * GB, WS_AK = WS_G0 + 1 * GB, WS_AV = WS_G0 + 2 * GB, WS_OZ = WS_G0 + 3 * GB;
constexpr size_t WS_BV = WS_G0 + 4 * GB, WS_SBZ = WS_G0 + 5 * GB;
constexpr size_t WS_SGA = WS_G0 + 6 * GB, WS_SGB = WS_G0 + 7 * GB;
constexpr size_t WS_YA = WS_G0 + 8 * GB, WS_YB = WS_G0 + 9 * GB;
constexpr size_t WS_MIX = WS_G0 + 10 * GB;
constexpr size_t WS_END = WS_G0 + 11 * GB;
constexpr size_t WS_STF = WS_END;
static_assert(WS_STF + GB <= 512 * MiB, "fw states fit the 512 MiB workspace");
constexpr size_t DO_BQ = 128 * MiB - 2 * GB, DO_BK = 128 * MiB - GB;

#define LAS __attribute__((address_space(3)))
typedef unsigned short bf16_t;
typedef short bf16x8 __attribute__((ext_vector_type(8)));
typedef short s16x4 __attribute__((ext_vector_type(4)));
typedef float f32x4 __attribute__((ext_vector_type(4)));
typedef float f32x2 __attribute__((ext_vector_type(2)));
typedef float f32x16 __attribute__((ext_vector_type(16)));
typedef unsigned u32x4 __attribute__((ext_vector_type(4)));
typedef unsigned u32x2 __attribute__((ext_vector_type(2)));

__device__ __forceinline__ float bf2f(unsigned short v) { return __uint_as_float((unsigned)v << 16); }
__device__ __forceinline__ unsigned f2bf(float f) { unsigned u = __float_as_uint(f); return (u + 0x7fffu + ((u >> 16) & 1u)) >> 16; }
__device__ __forceinline__ unsigned pk2(float lo, float hi) { return f2bf(lo) | (f2bf(hi) << 16); }
__device__ __forceinline__ float fast_exp(float x) { return __builtin_amdgcn_exp2f(x * 1.4426950408889634f); }
__device__ __forceinline__ float fast_sigmoid(float x) { return __builtin_amdgcn_rcpf(1.f + fast_exp(-x)); }
__device__ __forceinline__ float fast_silu(float x) { return x * fast_sigmoid(x); }
#define SHX(v, off) __builtin_bit_cast(float, __builtin_amdgcn_ds_bpermute(((lane) ^ (off)) << 2, __builtin_bit_cast(int, (float)(v))))
#define SHUP(v, off) __builtin_bit_cast(float, __builtin_amdgcn_ds_bpermute(((lane) - (off)) << 2, __builtin_bit_cast(int, (float)(v))))
__device__ __forceinline__ float wave_sum(float v, int lane) {
#pragma unroll
    for (int o = 1; o < 64; o <<= 1) v += SHX(v, o);
    return v;
}

__device__ __forceinline__ int opaque_tid() { int t = threadIdx.x; asm volatile("" : "+v"(t)); return t; }

struct Params {
    const float* x; const int* pos; const float* norm_g; const float* w_in; const float* ml_gate_b; const float* ml_conv_w;
    const float* ml_norm_g; const float* da_lambda; const float* da_subln_g; const float* gate_b; const float* w_a; const float* w_b;
    const float* w_out; const float* final_g;
    float* out; unsigned char* ws;
    int grp; int pad;
};

namespace pg8 {
#define PG8_LAS __attribute__((address_space(3)))
typedef unsigned short bf16_t;
typedef short bf16x8 __attribute__((ext_vector_type(8)));
typedef float f32x4 __attribute__((ext_vector_type(4)));
typedef unsigned u32x4 __attribute__((ext_vector_type(4)));
constexpr int BM = 256, BK = 64, HALF = 128, HTB = HALF * BK * 2  , STAGE_BYTES = 8 * HTB, NXCD = 8, WGM = 8;

__host__ __device__ __forceinline__ int lds_byte(int r, int c) { const int st = (r >> 4) * 2 + (c >> 5), rr = r & 15, cc = c & 31, ob = rr * 64 + cc * 2; return st * 1024 + (ob ^ (((ob >> 9) & 1) << 5)); }
__host__ __device__ __forceinline__ void stage_rc(int b, int& R, int& C) { const int st = b / 1024, sb = b % 1024, swz = sb ^ (((sb >> 9) & 1) << 5); R = (st >> 1) * 16 + swz / 64; C = (st & 1) * 32 + (swz % 64) / 2; }
__host__ __device__ __forceinline__ int perm32(int rho) { const int n = rho >> 4, i = rho & 15; return 8 * (i >> 2) + 4 * n + (i & 3); }

struct Unit { int pm, pn; };
struct Gemm { const bf16_t* A; const bf16_t* Bt; int M, N, K; };

struct StaticOrder {
    int nM, nN, nwg, G, c;
    __host__ __device__ void init(int M, int N, int G_, int c_) { nM = M / BM; nN = N / BM; nwg = nM * nN; G = G_; c = c_; }
    __host__ __device__ bool next(int i, Unit& u) const {
        const long L = (long)i * G + c; if (L >= nwg) return false;
        int wgid = (int)L; { const int q = nwg / NXCD, r = nwg % NXCD, xcd = wgid % NXCD, off = wgid / NXCD; wgid = (xcd < r ? xcd * (q + 1) : r * (q + 1) + (xcd - r) * q) + off; }
        const int nig = WGM * nN, gid = wgid / nig, fm = gid * WGM, gsz = (nM - fm) < WGM ? (nM - fm) : WGM;
        u.pm = fm + ((wgid % nig) % gsz); u.pn = (wgid % nig) / gsz; return true;
    }
    __device__ __forceinline__ void a_ready(const Unit&) const {}
    __device__ __forceinline__ void done(const Unit&) const {}
};

typedef __bf16 bf16x2_t __attribute__((ext_vector_type(2)));
typedef float f32x2_t __attribute__((ext_vector_type(2)));
__device__ __forceinline__ unsigned cvt_pk_bf16(float lo, float hi) { f32x2_t v = {lo, hi}; bf16x2_t b = __builtin_convertvector(v, bf16x2_t); return __builtin_bit_cast(unsigned, b); }

__host__ __device__ __forceinline__ int proj_orig_col(int n) {
    const int pn = n >> 8, c = n & 255;
    if (pn < 12) return pn * 256 + c;
    if (pn < 20) { const int i = pn - 12; return (c < 128 ? 3072 : 4096) + i * 128 + (c & 127); }
    if (pn < 28) { const int base = pn < 24 ? 5136 : 6160, q = (pn - 20) & 3, cc = c & 127; return base + (4 * q + (cc >> 5)) * 64 + (c >= 128 ? 32 : 0) + (cc & 31); }
    return 7184 + (pn - 28) * 256 + c;
}
__device__ __forceinline__ void store8(bf16_t* p, const f32x4 v0, const f32x4 v1) {
    u32x4 w; w.x = cvt_pk_bf16(v0[0], v0[1]); w.y = cvt_pk_bf16(v0[2], v0[3]); w.z = cvt_pk_bf16(v1[0], v1[1]); w.w = cvt_pk_bf16(v1[2], v1[3]);
    *(u32x4*)p = w;
}
__device__ __forceinline__ f32x4 sig4(f32x4 v) { f32x4 r; r[0] = fast_sigmoid(v[0]); r[1] = fast_sigmoid(v[1]); r[2] = fast_sigmoid(v[2]); r[3] = fast_sigmoid(v[3]); return r; }
__device__ __forceinline__ f32x4 silu4(f32x4 v) { f32x4 r; r[0] = fast_silu(v[0]); r[1] = fast_silu(v[1]); r[2] = fast_silu(v[2]); r[3] = fast_silu(v[3]); return r; }

constexpr float QSCALE = 0.125f * 1.4426950408889634f;
struct EpiProj {
    static constexpr bool PERM = true, AFTER_DRAIN = false;
    unsigned char* ws; unsigned char* dout; const float* gate_b; int grp;
    __device__ __forceinline__ void operator()(const f32x4 (&acc)[2][2][4][2], const Unit& u, int wr, int wc, int fr, int fq) const {
        const int pn = u.pn;
        const int r0 = u.pm * 256 + wr * 64 + fr;
        const int bl = r0 >> 13, s0 = r0 & (SEQ - 1);
        const int c8 = wc * 32 + 8 * fq;
        if (pn < 12) {
            const int kind = pn >> 2, h = pn & 3;
            bf16_t* base = (bf16_t*)(ws + (kind == 0 ? WS_AQ : kind == 1 ? WS_AK : WS_AV)) + ((size_t)(bl * 4 + h) * SEQ + s0) * 256 + c8;
#pragma unroll
            for (int ai = 0; ai < 2; ++ai)
#pragma unroll
                for (int m = 0; m < 4; ++m)
#pragma unroll
                    for (int bj = 0; bj < 2; ++bj) store8(base + (size_t)(ai * 128 + m * 16) * 256 + bj * 128, acc[ai][bj][m][0], acc[ai][bj][m][1]);
        } else if (pn < 20) {
            const int i = pn - 12, h = i >> 1;
            bf16_t* base = (bf16_t*)(ws + WS_OZ) + ((size_t)(bl * 4 + h) * SEQ + s0) * 256 + (i & 1) * 128 + c8;
#pragma unroll
            for (int ai = 0; ai < 2; ++ai)
#pragma unroll
                for (int m = 0; m < 4; ++m)
                    store8(base + (size_t)(ai * 128 + m * 16) * 256, sig4(acc[ai][0][m][0]) * silu4(acc[ai][1][m][0]), sig4(acc[ai][0][m][1]) * silu4(acc[ai][1][m][1]));
        } else if (pn < 28) {
            const bool isq = pn < 24; const int q = (pn - 20) & 3, head = 2 * q + (wc >> 1), map = wc & 1;
            bf16_t* base = (bf16_t*)(dout + (isq ? DO_BQ : DO_BK)) + ((size_t)(bl * 8 + head) * SEQ + s0) * 128 + map * 64 + 8 * fq;
            float kn2 = 0.f; const int lane = fq * 16 + fr;
            const f32x4* cs = (const f32x4*)(ws + WS_CS) + ((size_t)(grp * TG + r0) * 32 + 8 * fq) / 2;
#pragma unroll
            for (int ai = 0; ai < 2; ++ai)
#pragma unroll
                for (int m = 0; m < 4; ++m) {
                    const int ro = ai * 128 + m * 16;
                    const f32x4* c4 = cs + (size_t)ro * 16;
                    f32x4 o1[2], o2[2];
#pragma unroll
                    for (int n = 0; n < 2; ++n) {
                        const f32x4 ca = c4[2 * n], cb = c4[2 * n + 1];
                        const f32x4 t1 = acc[ai][0][m][n], t2 = acc[ai][1][m][n];
                        o1[n][0] = t1[0] * ca[0] - t2[0] * ca[1]; o2[n][0] = t2[0] * ca[0] + t1[0] * ca[1];
                        o1[n][1] = t1[1] * ca[2] - t2[1] * ca[3]; o2[n][1] = t2[1] * ca[2] + t1[1] * ca[3];
                        o1[n][2] = t1[2] * cb[0] - t2[2] * cb[1]; o2[n][2] = t2[2] * cb[0] + t1[2] * cb[1];
                        o1[n][3] = t1[3] * cb[2] - t2[3] * cb[3]; o2[n][3] = t2[3] * cb[2] + t1[3] * cb[3];
                    }
                    if (isq) { o1[0] = o1[0] * QSCALE; o1[1] = o1[1] * QSCALE; o2[0] = o2[0] * QSCALE; o2[1] = o2[1] * QSCALE; }
                    else { float n2 = 0.f;
#pragma unroll
                        for (int n = 0; n < 2; ++n)
#pragma unroll
                            for (int j = 0; j < 4; ++j) n2 += o1[n][j] * o1[n][j] + o2[n][j] * o2[n][j];
                        n2 += SHX(n2, 16); n2 += SHX(n2, 32);
                        kn2 = fmaxf(kn2, n2); }
                    store8(base + (size_t)ro * 128, o1[0], o1[1]); store8(base + (size_t)ro * 128 + 32, o2[0], o2[1]);
                }
            if (!isq) {
                kn2 = fmaxf(kn2, SHX(kn2, 1)); kn2 = fmaxf(kn2, SHX(kn2, 2)); kn2 = fmaxf(kn2, SHX(kn2, 4)); kn2 = fmaxf(kn2, SHX(kn2, 8));
                if (fr == 0 && fq == 0) atomicMax((unsigned*)(ws + WS_KMAX) + ((size_t)(grp * NG + bl) * 8 + head) * 2 + map, __float_as_uint(kn2));
            }
        } else if (pn < 36) {
            const bool isz = pn >= 32; const int q = (pn - 28) & 3;
#pragma unroll
            for (int bj = 0; bj < 2; ++bj) {
                const int head = 2 * q + bj;
                bf16_t* base = (bf16_t*)(ws + (isz ? WS_SBZ : WS_BV)) + ((size_t)(bl * 8 + head) * SEQ + s0) * 128 + c8;
#pragma unroll
                for (int ai = 0; ai < 2; ++ai)
#pragma unroll
                    for (int m = 0; m < 4; ++m) {
                        f32x4 v0 = acc[ai][bj][m][0], v1 = acc[ai][bj][m][1];
                        if (isz) { v0 = silu4(v0); v1 = silu4(v1); }
                        store8(base + (size_t)(ai * 128 + m * 16) * 128, v0, v1);
                    }
            }
        } else {
            const bool isa = pn < 40; const int cb = ((pn - 36) & 3) * 256;
#pragma unroll
            for (int bj = 0; bj < 2; ++bj) {
                bf16_t* base = (bf16_t*)(ws + (isa ? WS_SGA : WS_SGB)) + (size_t)r0 * 1024 + cb + bj * 128 + c8;
                const float* bp = gate_b + (isa ? 0 : 1024) + cb + bj * 128 + c8;
                const f32x4 b0 = *(const f32x4*)bp, b1 = *(const f32x4*)(bp + 4);
#pragma unroll
                for (int ai = 0; ai < 2; ++ai)
#pragma unroll
                    for (int m = 0; m < 4; ++m)
                        store8(base + (size_t)(ai * 128 + m * 16) * 1024, sig4(acc[ai][bj][m][0] + b0), sig4(acc[ai][bj][m][1] + b1));
            }
        }
    }
};

__device__ __forceinline__ f32x4 bf4lo(const u32x4 w) { return (f32x4){__uint_as_float(w.x << 16), __uint_as_float(w.x & 0xffff0000u), __uint_as_float(w.y << 16), __uint_as_float(w.y & 0xffff0000u)}; }
__device__ __forceinline__ f32x4 bf4hi(const u32x4 w) { return (f32x4){__uint_as_float(w.z << 16), __uint_as_float(w.z & 0xffff0000u), __uint_as_float(w.w << 16), __uint_as_float(w.w & 0xffff0000u)}; }
template <bool ADD> struct EpiMix {
    static constexpr bool PERM = true, AFTER_DRAIN = false;
    const bf16_t* gate; bf16_t* mix;
    __device__ __forceinline__ void operator()(const f32x4 (&acc)[2][2][4][2], const Unit& u, int wr, int wc, int fr, int fq) const {
        const int r0 = u.pm * 256 + wr * 64 + fr, c0 = u.pn * 256 + wc * 32 + 8 * fq;
#pragma unroll
        for (int ai = 0; ai < 2; ++ai)
#pragma unroll
            for (int m = 0; m < 4; ++m)
#pragma unroll
                for (int bj = 0; bj < 2; ++bj) {
                    const size_t off = (size_t)(r0 + ai * 128 + m * 16) * 1024 + c0 + bj * 128;
                    const u32x4 g = *(const u32x4*)(gate + off);
                    f32x4 v0 = acc[ai][bj][m][0] * bf4lo(g), v1 = acc[ai][bj][m][1] * bf4hi(g);
                    if (ADD) { const u32x4 o = *(const u32x4*)(mix + off); v0 = v0 + bf4lo(o); v1 = v1 + bf4hi(o); }
                    store8(mix + off, v0, v1);
                }
    }
};
struct EpiResid {
    static constexpr bool PERM = false, AFTER_DRAIN = false;
    const float* resid; float* out;
    __device__ __forceinline__ void operator()(const f32x4 (&acc)[2][2][4][2], const Unit& u, int wr, int wc, int fr, int fq) const {
        const int r0 = u.pm * 256 + wr * 64 + fr, c0 = u.pn * 256 + wc * 32 + 4 * fq;
#pragma unroll
        for (int ai = 0; ai < 2; ++ai)
#pragma unroll
            for (int m = 0; m < 4; ++m)
#pragma unroll
                for (int bj = 0; bj < 2; ++bj)
#pragma unroll
                    for (int n = 0; n < 2; ++n) {
                        const size_t off = (size_t)(r0 + ai * 128 + m * 16) * 1024 + c0 + bj * 128 + n * 16;
                        *(f32x4*)(out + off) = *(const f32x4*)(resid + off) + acc[ai][bj][m][n];
                    }
    }
};
template <class Epi, class Sched, bool ALIGN_EPI = false, bool SP2 = false>
__device__ __forceinline__ void gemm_phase(PG8_LAS unsigned char* lds, const Gemm g, const Sched& S, const Epi& E) {
    const int tid = opaque_tid(), wid = __builtin_amdgcn_readfirstlane(tid >> 6), lane = tid & 63, wr = wid >> 2, wc = wid & 3, fr = lane & 15, fq = lane >> 4;
    const int K = g.K, nt = K / BK;
    unsigned voffA[2], voffB[2];
#pragma unroll
    for (int i = 0; i < 2; ++i) { int R, C; stage_rc(tid * 16 + i * 8192, R, C); const int Rb = Epi::PERM ? ((R & ~31) + perm32(R & 31)) : R;
        voffA[i] = (unsigned)(R * K + C) * 2u; voffB[i] = (unsigned)(Rb * K + C) * 2u; }
    const size_t kstep = (size_t)(BK * 2);
    const size_t hstep = (size_t)HALF * K * 2;
    const size_t tstep = 2 * hstep;
    const unsigned ldsw = (unsigned)wid * 1024u;
    const int aoff = lds_byte(wr * 64 + fr, fq * 8), boff = lds_byte(wc * 32 + fr, fq * 8);
#define PG8_SA(b, h) (((b) * 2 + (h)) * HTB)
#define PG8_SB(b, h) ((4 + (b) * 2 + (h)) * HTB)
#define PG8_STAGE(bufoff, gbase, voff) do { _Pragma("unroll") for (int _i = 0; _i < 2; ++_i) \
        __builtin_amdgcn_global_load_lds((const unsigned*)((const char*)(gbase) + (voff)[_i]), (PG8_LAS unsigned*)(lds + (bufoff) + ldsw + _i * 8192), 16, 0, 0); } while (0)
#define PG8_LDA(dst, b, h) do { _Pragma("unroll") for (int m = 0; m < 4; ++m) _Pragma("unroll") for (int k = 0; k < 2; ++k) dst[m][k] = *(const PG8_LAS bf16x8*)(lds + PG8_SA(b, h) + aoff + m * 2048 + k * 1024); } while (0)
#define PG8_LDB(dst, b, h) do { _Pragma("unroll") for (int n = 0; n < 2; ++n) _Pragma("unroll") for (int k = 0; k < 2; ++k) dst[n][k] = *(const PG8_LAS bf16x8*)(lds + PG8_SB(b, h) + boff + n * 2048 + k * 1024); } while (0)
#define PG8_MMA(ai, bj, At, Bt) do { __builtin_amdgcn_s_setprio(1); _Pragma("unroll") for (int m = 0; m < 4; ++m) _Pragma("unroll") for (int n = 0; n < 2; ++n) _Pragma("unroll") for (int k = 0; k < 2; ++k) \
        acc[ai][bj][m][n] = __builtin_amdgcn_mfma_f32_16x16x32_bf16(Bt[n][k], At[m][k], acc[ai][bj][m][n], 0, 0, 0); __builtin_amdgcn_s_setprio(0); } while (0)
#define PG8_WAIT_V(n) asm volatile("s_waitcnt vmcnt(" #n ")" ::: "memory")
#define PG8_WAIT_L(n) asm volatile("s_waitcnt lgkmcnt(" #n ")" ::: "memory")
#define PG8_BAR __builtin_amdgcn_s_barrier()
#define PG8_SCHED __builtin_amdgcn_sched_barrier(0)
    Unit cur, nxt; int ui = 0;
    if (!S.next(0, cur)) return;
    f32x4 acc[2][2][4][2];
#pragma unroll
    for (int a = 0; a < 2; ++a)
#pragma unroll
        for (int b = 0; b < 2; ++b)
#pragma unroll
            for (int m = 0; m < 4; ++m)
#pragma unroll
                for (int n = 0; n < 2; ++n) acc[a][b][m][n] = (f32x4){0.f, 0.f, 0.f, 0.f};
    bf16x8 At[4][2], B0[2][2], B1[2][2];
    const char* cA = (const char*)g.A + (size_t)cur.pm * tstep; const char* cB = (const char*)g.Bt + (size_t)cur.pn * tstep;
    S.a_ready(cur);
    if constexpr (SP2) {
        PG8_STAGE(PG8_SB(0, 0), cB, voffB); PG8_STAGE(PG8_SB(0, 1), cB + hstep, voffB); PG8_STAGE(PG8_SA(0, 0), cA, voffA); PG8_STAGE(PG8_SA(0, 1), cA + hstep, voffA);
        if (wr == 1) PG8_BAR;
        PG8_WAIT_V(2); PG8_BAR;
        PG8_STAGE(PG8_SB(1, 0), cB + kstep, voffB); PG8_STAGE(PG8_SA(1, 0), cA + kstep, voffA); PG8_STAGE(PG8_SB(1, 1), cB + hstep + kstep, voffB);
        PG8_WAIT_V(6); PG8_BAR;
    } else {
        PG8_STAGE(PG8_SB(0, 0), cB, voffB); PG8_STAGE(PG8_SA(0, 0), cA, voffA); PG8_STAGE(PG8_SB(0, 1), cB + hstep, voffB); PG8_STAGE(PG8_SA(0, 1), cA + hstep, voffA);
        if (wr == 1) PG8_BAR;
        PG8_WAIT_V(4); PG8_BAR;
        PG8_STAGE(PG8_SB(1, 0), cB + kstep, voffB); PG8_STAGE(PG8_SA(1, 0), cA + kstep, voffA); PG8_STAGE(PG8_SB(1, 1), cB + hstep + kstep, voffB);
        PG8_WAIT_V(6); PG8_BAR;
    }
    for (;;) {
        const bool has_next = S.next(ui + 1, nxt);
        const char* nA = has_next ? (const char*)g.A + (size_t)nxt.pm * tstep : cA; const char* nB = has_next ? (const char*)g.Bt + (size_t)nxt.pn * tstep : cB;
        for (int t = 0; t < nt; t += 2) {
            const bool last = (t == nt - 2);
            const char* a1 = cA + (size_t)(t + 1) * kstep;
            const char* a2 = last ? nA : cA + (size_t)(t + 2) * kstep; const char* b2 = last ? nB : cB + (size_t)(t + 2) * kstep;
            const char* a3 = a2 + kstep; const char* b3 = b2 + kstep;
            if (last && has_next) S.a_ready(nxt);
            if constexpr (SP2) {
            PG8_LDB(B0, 0, 0); PG8_LDB(B1, 0, 1); PG8_SCHED; PG8_LDA(At, 0, 0); PG8_STAGE(PG8_SA(1, 1), a1 + hstep, voffA);
            PG8_WAIT_V(8); PG8_WAIT_L(0); PG8_BAR; PG8_MMA(0, 0, At, B0); PG8_MMA(0, 1, At, B1); PG8_BAR; PG8_SCHED;
            PG8_LDA(At, 0, 1); PG8_STAGE(PG8_SB(0, 0), b2, voffB); PG8_STAGE(PG8_SB(0, 1), b2 + hstep, voffB); PG8_STAGE(PG8_SA(0, 0), a2, voffA);
            PG8_WAIT_V(8); PG8_WAIT_L(0); PG8_BAR; PG8_MMA(1, 0, At, B0); PG8_MMA(1, 1, At, B1); PG8_BAR; PG8_SCHED;
            PG8_LDB(B0, 1, 0); PG8_LDB(B1, 1, 1); PG8_SCHED; PG8_LDA(At, 1, 0); PG8_STAGE(PG8_SA(0, 1), a2 + hstep, voffA);
            PG8_WAIT_V(8); PG8_WAIT_L(0); PG8_BAR; PG8_MMA(0, 0, At, B0); PG8_MMA(0, 1, At, B1); PG8_BAR; PG8_SCHED;
            PG8_LDA(At, 1, 1); PG8_STAGE(PG8_SB(1, 0), b3, voffB); PG8_STAGE(PG8_SB(1, 1), b3 + hstep, voffB); PG8_STAGE(PG8_SA(1, 0), a3, voffA);
            PG8_WAIT_V(8); PG8_WAIT_L(0); PG8_BAR; PG8_MMA(1, 0, At, B0); PG8_MMA(1, 1, At, B1); PG8_BAR; PG8_SCHED;
            } else {
            PG8_LDB(B0, 0, 0); PG8_SCHED; PG8_LDA(At, 0, 0); PG8_STAGE(PG8_SA(1, 1), a1 + hstep, voffA);
            PG8_WAIT_L(8); PG8_BAR; PG8_WAIT_L(0); PG8_MMA(0, 0, At, B0); PG8_BAR; PG8_SCHED;
            PG8_LDB(B1, 0, 1); PG8_STAGE(PG8_SB(0, 0), b2, voffB);
            PG8_BAR; PG8_WAIT_L(0); PG8_MMA(0, 1, At, B1); PG8_BAR;
            PG8_LDA(At, 0, 1); PG8_STAGE(PG8_SA(0, 0), a2, voffA);
            PG8_BAR; PG8_WAIT_L(0); PG8_MMA(1, 0, At, B0); PG8_BAR; PG8_SCHED;
            PG8_STAGE(PG8_SB(0, 1), b2 + hstep, voffB);
            PG8_WAIT_V(6); PG8_BAR; PG8_MMA(1, 1, At, B1); PG8_BAR;
            PG8_LDB(B0, 1, 0); PG8_SCHED; PG8_LDA(At, 1, 0); PG8_STAGE(PG8_SA(0, 1), a2 + hstep, voffA);
            PG8_WAIT_L(8); PG8_BAR; PG8_WAIT_L(0); PG8_MMA(0, 0, At, B0); PG8_BAR; PG8_SCHED;
            PG8_LDB(B1, 1, 1); PG8_STAGE(PG8_SB(1, 0), b3, voffB);
            PG8_BAR; PG8_WAIT_L(0); PG8_MMA(0, 1, At, B1); PG8_BAR;
            PG8_LDA(At, 1, 1); PG8_STAGE(PG8_SA(1, 0), a3, voffA);
            PG8_BAR; PG8_WAIT_L(0); PG8_MMA(1, 0, At, B0); PG8_BAR; PG8_SCHED;
            PG8_STAGE(PG8_SB(1, 1), b3 + hstep, voffB);
            PG8_WAIT_V(6); PG8_BAR; PG8_MMA(1, 1, At, B1); PG8_BAR;
            }
        }
        if constexpr (ALIGN_EPI) { if (wr == 0) PG8_BAR; }
        if constexpr (!Epi::AFTER_DRAIN) { E(acc, cur, wr, wc, fr, fq); S.done(cur); }
        if (!has_next) break;
#pragma unroll
        for (int a = 0; a < 2; ++a)
#pragma unroll
            for (int b = 0; b < 2; ++b)
#pragma unroll
                for (int m = 0; m < 4; ++m)
#pragma unroll
                    for (int n = 0; n < 2; ++n) acc[a][b][m][n] = (f32x4){0.f, 0.f, 0.f, 0.f};
        cur = nxt; cA = nA; cB = nB; ++ui;
        if constexpr (ALIGN_EPI) { if (wr == 1) PG8_BAR; }
    }
    PG8_WAIT_V(0);
    if constexpr (!ALIGN_EPI) { if (wr == 0) PG8_BAR; }
    PG8_BAR;
    if constexpr (Epi::AFTER_DRAIN) { E.fused(acc, cur, wr, wc, fr, fq, lds, wid, lane); S.done(cur); }
#undef PG8_SA
#undef PG8_SB
#undef PG8_STAGE
#undef PG8_LDA
#undef PG8_LDB
#undef PG8_MMA
#undef PG8_WAIT_V
#undef PG8_WAIT_L
#undef PG8_BAR
#undef PG8_SCHED
}
}

constexpr int LDS_BYTES = 163840;

__device__ __forceinline__ int vcu_of(int bx, int G) { return (G % 8 == 0) ? (bx % 8) * (G / 8) + bx / 8 : bx; }

__device__ __forceinline__ void p0_transpose_item(const float* W, int ldw, int col0, int k0, bf16_t* WTrow0, int K, LAS float* scr, int lane) {
#pragma unroll 8
    for (int i = 0; i < 32; ++i) { const int kk = 2 * i + (lane >> 5); scr[kk * 33 + (lane & 31)] = W[(size_t)(k0 + kk) * ldw + col0 + (lane & 31)]; }
    asm volatile("s_waitcnt lgkmcnt(0)" ::: "memory");
    const int c = lane & 7;
#pragma unroll
    for (int j = 0; j < 4; ++j) { const int n = (lane >> 3) + 8 * j; const LAS float* s = scr + (8 * c) * 33 + n;
        u32x4 o; o.x = pk2(s[0 * 33], s[1 * 33]); o.y = pk2(s[2 * 33], s[3 * 33]); o.z = pk2(s[4 * 33], s[5 * 33]); o.w = pk2(s[6 * 33], s[7 * 33]);
        *(u32x4*)(WTrow0 + (size_t)n * K + k0 + 8 * c) = o; }
    asm volatile("s_waitcnt lgkmcnt(0)" ::: "memory");
}

__device__ __forceinline__ void phase_prologue(const Params& p, LAS unsigned char* lds) {
    const int tid = opaque_tid(), lane = tid & 63, wave = __builtin_amdgcn_readfirstlane(tid >> 6);
    const int G = gridDim.x, gw = blockIdx.x * NWAVES + wave, NGW = G * NWAVES;
    unsigned char* ws = p.ws;
    {
        LAS float* scr = (LAS float*)(lds + wave * 16384);
        constexpr int I_IN = 16 * (NPROJ / 32), I_SQ = 16 * 32;
        for (int it = gw; it < I_IN + 3 * I_SQ; it += NGW) {
            if (it < I_IN) { const int kb = it / (NPROJ / 32), nb = it % (NPROJ / 32);
                p0_transpose_item(p.w_in, PW, pg8::proj_orig_col(nb * 32), kb * 64, (bf16_t*)(ws + WS_WIN) + (size_t)(nb * 32) * DM, DM, scr, lane); }
            else { const int r = it - I_IN, wsel = r / I_SQ, rr = r % I_SQ, kb = rr / 32, nb = rr % 32;
                const float* W = wsel == 0 ? p.w_a : wsel == 1 ? p.w_b : p.w_out;
                bf16_t* WT = (bf16_t*)(ws + (wsel == 0 ? WS_WA : wsel == 1 ? WS_WB : WS_WO));
                p0_transpose_item(W, DM, nb * 32, kb * 64, WT + (size_t)(nb * 32) * DM, DM, scr, lane); }
        }
    }
    for (int e = blockIdx.x * NTHR + tid; e < TOK * 32; e += G * NTHR) {
        const int t = e >> 5, i = e & 31;
        const float inv = (float)exp(-(double)(2 * i) * (9.210340371976184 / 64.0));
        const float ang = (float)p.pos[t] * inv;
        double rev = (double)ang * 0.15915494309189535; rev -= rint(rev);
        f32x2 cs; cs.x = __builtin_amdgcn_cosf((float)rev); cs.y = __builtin_amdgcn_sinf((float)rev);
        ((f32x2*)(ws + WS_CS))[e] = cs;
    }
    if (blockIdx.x == 0 && tid == 0) {
        float a = 0.f, b = 0.f;
        for (int i = 0; i < 64; ++i) { a += p.da_lambda[i] * p.da_lambda[64 + i]; b += p.da_lambda[128 + i] * p.da_lambda[192 + i]; }
        ((float*)(ws + WS_MISC))[0] = expf(a) - expf(b) + 0.2f;
    }
    __syncthreads();
    LAS float* wg = (LAS float*)lds;
    for (int k = tid; k < DM; k += NTHR) {
        const float* src = p.w_in + (size_t)k * PW + 5120;
#pragma unroll
        for (int q = 0; q < 4; ++q) { const f32x4 v = *(const f32x4*)(src + 4 * q);
            wg[(4 * q + 0) * DM + k] = v[0]; wg[(4 * q + 1) * DM + k] = v[1]; wg[(4 * q + 2) * DM + k] = v[2]; wg[(4 * q + 3) * DM + k] = v[3]; }
    }
    __syncthreads();
    f32x4 vn[4];
    if (gw < TOK) { const f32x4* xr = (const f32x4*)(p.x + (size_t)gw * DM) + lane;
#pragma unroll
        for (int j = 0; j < 4; ++j) vn[j] = xr[64 * j]; }
    for (int m = gw; m < TOK; m += NGW) {
        f32x4 v[4]; float s = 0.f;
#pragma unroll
        for (int j = 0; j < 4; ++j) { v[j] = vn[j]; s += (v[j][0] * v[j][0] + v[j][1] * v[j][1]) + (v[j][2] * v[j][2] + v[j][3] * v[j][3]); }
        if (m + NGW < TOK) { const f32x4* xr = (const f32x4*)(p.x + (size_t)(m + NGW) * DM) + lane;
#pragma unroll
            for (int j = 0; j < 4; ++j) vn[j] = xr[64 * j]; }
        const float rstd = rsqrtf(wave_sum(s, lane) * (1.f / DM) + 1e-6f);
#pragma unroll
        for (int j = 0; j < 4; ++j) { const f32x4 g = *((const f32x4*)p.norm_g + lane + 64 * j); v[j] = v[j] * rstd * g; }
        unsigned long long* o8 = (unsigned long long*)((bf16_t*)(ws + WS_HBF) + (size_t)m * DM) + lane;
#pragma unroll
        for (int j = 0; j < 4; ++j) o8[64 * j] = (unsigned long long)pk2(v[j][0], v[j][1]) | ((unsigned long long)pk2(v[j][2], v[j][3]) << 32);
        float a[16];
#pragma unroll
        for (int gi = 0; gi < 16; ++gi) {
            float acc = 0.f;
            asm volatile("" ::: "memory");
#pragma unroll
            for (int j = 0; j < 4; ++j) { const f32x4 w = *(const LAS f32x4*)(wg + gi * DM + 4 * lane + 256 * j); acc += (v[j][0] * w[0] + v[j][1] * w[1]) + (v[j][2] * w[2] + v[j][3] * w[3]); }
            a[gi] = acc;
        }
        float e;
        { const bool h5 = lane & 32, h4 = lane & 16, h3 = lane & 8, h2 = lane & 4;
          float b8[8], c4[4], d2[2];
#pragma unroll
          for (int i = 0; i < 8; ++i) { const float give = h5 ? a[i] : a[i + 8], keep = h5 ? a[i + 8] : a[i]; b8[i] = keep + SHX(give, 32); }
#pragma unroll
          for (int i = 0; i < 4; ++i) { const float give = h4 ? b8[i] : b8[i + 4], keep = h4 ? b8[i + 4] : b8[i]; c4[i] = keep + SHX(give, 16); }
#pragma unroll
          for (int i = 0; i < 2; ++i) { const float give = h3 ? c4[i] : c4[i + 2], keep = h3 ? c4[i + 2] : c4[i]; d2[i] = keep + SHX(give, 8); }
          { const float give = h2 ? d2[0] : d2[1], keep = h2 ? d2[1] : d2[0]; e = keep + SHX(give, 4); }
          e += SHX(e, 1); e += SHX(e, 2); }
        if ((lane & 3) == 0) ((float*)(ws + WS_GATE))[(size_t)m * 16 + ((lane >> 5) & 1) * 8 + ((lane >> 4) & 1) * 4 + ((lane >> 3) & 1) * 2 + ((lane >> 2) & 1)] = e;
    }
}

__device__ __forceinline__ void phase_inproj(const Params& p, LAS unsigned char* lds, int grp) {
    pg8::Gemm g{(const bf16_t*)(p.ws + WS_HBF) + (size_t)grp * TG * DM, (const bf16_t*)(p.ws + WS_WIN), TG, NPROJ, DM};
    pg8::StaticOrder S; S.init(TG, NPROJ, gridDim.x, (int)blockIdx.x);
    pg8::EpiProj E{p.ws, (unsigned char*)p.out, p.gate_b, grp};
    pg8::gemm_phase<pg8::EpiProj, pg8::StaticOrder, true, true>(lds, g, S, E);
}

namespace att {
constexpr int KVBLK = 64;
constexpr float SCALE = 0.125f, THR = 8.f;
constexpr int SHM_V = KVBLK * 128 * 2, SHM_K = KVBLK * 128 * 2, SHM_ATTN = 2 * SHM_V + 2 * SHM_K + NWAVES * 64 * 4;
#define KSWZ(row, colB) ((row) * 256 + ((colB) ^ (((row) & 7) << 4)))
#define SBAR() __builtin_amdgcn_sched_barrier(0)
__device__ __forceinline__ int crow(int r, int hi) { return (r & 3) + 8 * (r >> 2) + 4 * hi; }
__device__ __forceinline__ unsigned cvtpk(float lo, float hi) { return pg8::cvt_pk_bf16(lo, hi); }

__device__ __forceinline__ void expHalf(f32x16& p) {
#pragma unroll
    for (int r = 0; r < 16; ++r) p[r] = __builtin_amdgcn_exp2f(p[r]);
}
__device__ __forceinline__ void packP(const f32x16& p0, const f32x16& p1, bf16x8& pa0, bf16x8& pa1, bf16x8& pa2, bf16x8& pa3) {
#define PK4(P, BASE, OUT) do { unsigned a0 = cvtpk(P[BASE + 0], P[BASE + 1]), a1 = cvtpk(P[BASE + 2], P[BASE + 3]);   \
    unsigned b0 = cvtpk(P[BASE + 4], P[BASE + 5]), b1 = cvtpk(P[BASE + 6], P[BASE + 7]);                              \
    auto r0 = __builtin_amdgcn_permlane32_swap(a0, b0, false, false); auto r1 = __builtin_amdgcn_permlane32_swap(a1, b1, false, false); \
    u32x4 w = {r0[0], r1[0], r0[1], r1[1]}; OUT = *reinterpret_cast<bf16x8*>(&w); } while (0)
    PK4(p0, 0, pa0); PK4(p0, 8, pa1); PK4(p1, 0, pa2); PK4(p1, 8, pa3);
#undef PK4
}
__device__ __forceinline__ void qkt(f32x16& p0, f32x16& p1, const char* Ks, const bf16x8* qr, float negm, int g, int r32, int hi) {
#pragma unroll
    for (int r = 0; r < 16; ++r) { p0[r] = negm; p1[r] = negm; }
#pragma unroll
    for (int d0 = 0; d0 < 4; ++d0) { const int cb = ((g * 4 + d0) * 16 + hi * 8) * 2;
        const bf16x8 b0 = *reinterpret_cast<const bf16x8*>(Ks + KSWZ(r32, cb));
        const bf16x8 b1 = *reinterpret_cast<const bf16x8*>(Ks + KSWZ(32 + r32, cb));
        p0 = __builtin_amdgcn_mfma_f32_32x32x16_bf16(b0, qr[d0], p0, 0, 0, 0);
        p1 = __builtin_amdgcn_mfma_f32_32x32x16_bf16(b1, qr[d0], p1, 0, 0, 0); }
}
__device__ __forceinline__ int v_st(int k, int c) { const int kk = (k & ~0xC) | ((k & 4) << 1) | ((k & 8) >> 1); return ((kk >> 3) * 4 + (c >> 5)) * 512 + ((kk & 7) * 32 + (c & 31)) * 2; }
__device__ __forceinline__ int v_rd_base(int lane) { return ((lane & 3) << 3) | (((lane >> 2) & 3) << 6) | (((lane >> 4) & 1) << 5) | (((lane >> 5) & 1) << 8); }
constexpr int v_rd_off(int d0, int ks, int half) { return d0 * 512 + ks * 4096 + half * 2048; }
template <int OFF> __device__ __forceinline__ s16x4 tr_read(int vb) {
    s16x4 r; asm volatile("ds_read_b64_tr_b16 %0, %1 offset:%2" : "=&v"(r) : "v"(vb), "i"(OFF) : "memory"); return r;
}
#define PV_LOAD8(R, D0) const s16x4 R##0 = tr_read<v_rd_off(D0, 0, 0)>(vb), R##1 = tr_read<v_rd_off(D0, 0, 1)>(vb), R##2 = tr_read<v_rd_off(D0, 1, 0)>(vb), R##3 = tr_read<v_rd_off(D0, 1, 1)>(vb), \
    R##4 = tr_read<v_rd_off(D0, 2, 0)>(vb), R##5 = tr_read<v_rd_off(D0, 2, 1)>(vb), R##6 = tr_read<v_rd_off(D0, 3, 0)>(vb), R##7 = tr_read<v_rd_off(D0, 3, 1)>(vb)
#define PV_PK(L, H) (bf16x8){L[0], L[1], L[2], L[3], H[0], H[1], H[2], H[3]}
#define PV_MMA4(OD, R) do { OD = __builtin_amdgcn_mfma_f32_32x32x16_bf16(pa0, PV_PK(R##0, R##1), OD, 0, 0, 0); OD = __builtin_amdgcn_mfma_f32_32x32x16_bf16(pa1, PV_PK(R##2, R##3), OD, 0, 0, 0); \
    OD = __builtin_amdgcn_mfma_f32_32x32x16_bf16(pa2, PV_PK(R##4, R##5), OD, 0, 0, 0); OD = __builtin_amdgcn_mfma_f32_32x32x16_bf16(pa3, PV_PK(R##6, R##7), OD, 0, 0, 0); } while (0)
__device__ __forceinline__ void pv_d0(f32x16* o, f32x16& lacc, int vb, bf16x8 pa0, bf16x8 pa1, bf16x8 pa2, bf16x8 pa3) {
    const bf16x8 ones = {0x3F80, 0x3F80, 0x3F80, 0x3F80, 0x3F80, 0x3F80, 0x3F80, 0x3F80};
    PV_LOAD8(a, 0); SBAR();
    lacc = __builtin_amdgcn_mfma_f32_32x32x16_bf16(pa0, ones, lacc, 0, 0, 0); lacc = __builtin_amdgcn_mfma_f32_32x32x16_bf16(pa1, ones, lacc, 0, 0, 0);
    lacc = __builtin_amdgcn_mfma_f32_32x32x16_bf16(pa2, ones, lacc, 0, 0, 0); lacc = __builtin_amdgcn_mfma_f32_32x32x16_bf16(pa3, ones, lacc, 0, 0, 0);
    SBAR(); PV_LOAD8(b, 1); asm volatile("s_waitcnt lgkmcnt(8)" ::: "memory"); SBAR(); PV_MMA4(o[0], a);
    SBAR(); PV_LOAD8(c, 2); asm volatile("s_waitcnt lgkmcnt(8)" ::: "memory"); SBAR(); PV_MMA4(o[1], b);
    SBAR(); PV_LOAD8(d, 3); asm volatile("s_waitcnt lgkmcnt(8)" ::: "memory"); SBAR(); PV_MMA4(o[2], c);
    asm volatile("s_waitcnt lgkmcnt(0)" ::: "memory"); SBAR(); PV_MMA4(o[3], d);
}
#undef PV_LOAD8
#undef PV_PK
#undef PV_MMA4

#define TR_LOAD8(R, D0) do { R##0 = tr_read<v_rd_off(D0, 0, 0)>(vb); R##1 = tr_read<v_rd_off(D0, 0, 1)>(vb); R##2 = tr_read<v_rd_off(D0, 1, 0)>(vb); R##3 = tr_read<v_rd_off(D0, 1, 1)>(vb); \
    R##4 = tr_read<v_rd_off(D0, 2, 0)>(vb); R##5 = tr_read<v_rd_off(D0, 2, 1)>(vb); R##6 = tr_read<v_rd_off(D0, 3, 0)>(vb); R##7 = tr_read<v_rd_off(D0, 3, 1)>(vb); } while (0)
#define TR_PK(L, H) (bf16x8){L[0], L[1], L[2], L[3], H[0], H[1], H[2], H[3]}
#define TR_MMA4(OD, R) do { OD = __builtin_amdgcn_mfma_f32_32x32x16_bf16(po0, TR_PK(R##0, R##1), OD, 0, 0, 0); OD = __builtin_amdgcn_mfma_f32_32x32x16_bf16(po1, TR_PK(R##2, R##3), OD, 0, 0, 0); \
    OD = __builtin_amdgcn_mfma_f32_32x32x16_bf16(po2, TR_PK(R##4, R##5), OD, 0, 0, 0); OD = __builtin_amdgcn_mfma_f32_32x32x16_bf16(po3, TR_PK(R##6, R##7), OD, 0, 0, 0); } while (0)
#define EXP8(P, B) do { _Pragma("unroll") for (int _r = 0; _r < 8; ++_r) P[(B) + _r] = __builtin_amdgcn_exp2f(P[(B) + _r]); } while (0)
#define SUM8(P, B) do { ls[0] += P[(B) + 0] + P[(B) + 4]; ls[1] += P[(B) + 1] + P[(B) + 5]; ls[2] += P[(B) + 2] + P[(B) + 6]; ls[3] += P[(B) + 3] + P[(B) + 7]; } while (0)
#define CVT4(P, B, W) do { W[0] = cvtpk(P[(B) + 0], P[(B) + 1]); W[1] = cvtpk(P[(B) + 2], P[(B) + 3]); W[2] = cvtpk(P[(B) + 4], P[(B) + 5]); W[3] = cvtpk(P[(B) + 6], P[(B) + 7]); } while (0)
#define SWAP4(W, OUT) do { auto _r0 = __builtin_amdgcn_permlane32_swap(W[0], W[2], false, false); auto _r1 = __builtin_amdgcn_permlane32_swap(W[1], W[3], false, false); \
    u32x4 _w = {_r0[0], _r1[0], _r0[1], _r1[1]}; OUT = *reinterpret_cast<bf16x8*>(&_w); } while (0)
#define WAITL0() asm volatile("s_waitcnt lgkmcnt(0)" ::: "memory")
#define TRL(R, D0, I0, I1, I2, I3) do { R##I0 = tr_read<v_rd_off(D0, I0 >> 1, I0 & 1)>(vb); R##I1 = tr_read<v_rd_off(D0, I1 >> 1, I1 & 1)>(vb); R##I2 = tr_read<v_rd_off(D0, I2 >> 1, I2 & 1)>(vb); R##I3 = tr_read<v_rd_off(D0, I3 >> 1, I3 & 1)>(vb); } while (0)
#define MMO(OD, PO, L, H) OD = __builtin_amdgcn_mfma_f32_32x32x16_bf16(PO, TR_PK(L, H), OD, 0, 0, 0)
#define EX(P, I) P[I] = __builtin_amdgcn_exp2f(P[I])
#define AD(P, I) do { ls[(I) & 3] += P[I]; asm volatile("" : "+v"(ls[(I) & 3])); } while (0)
#define CV(W, J, P, I) W[J] = cvtpk(P[I], P[(I) + 1])
#define KLD(DST, D0) do { const int _cb = ((g * 4 + (D0)) * 16 + hi * 8) * 2; DST[0] = *reinterpret_cast<const bf16x8*>(Ks + KSWZ(r32, _cb)); DST[1] = *reinterpret_cast<const bf16x8*>(Ks + KSWZ(32 + r32, _cb)); } while (0)
template <bool DO_QT, bool DO_QK, bool DO_SM, bool DO_PV, bool DK, bool DV>
__device__ __forceinline__ void step3(bf16x8 (&kc)[2][2], const bf16_t* kg, const bf16_t* vg, char* kd, char* vd, unsigned koff, unsigned voff, f32x16* o, float (&ls)[4], int vb, const char* Ks, const bf16x8* qr, float negm, int g, int r32, int hi, f32x16& c0, f32x16& c1, f32x16& n0, f32x16& n1,
                                      bf16x8 po0, bf16x8 po1, bf16x8 po2, bf16x8 po3, bf16x8& pn0, bf16x8& pn1, bf16x8& pn2, bf16x8& pn3) {
    s16x4 a0, a1, a2, a3, a4, a5, a6, a7, b0, b1, b2, b3, b4, b5, b6, b7;
    unsigned w0[4], w1[4], w2[4], w3[4];
    bf16x8 kf[2][2];
#define TR2(R, D0, I0, I1) do { R##I0 = tr_read<v_rd_off(D0, I0 >> 1, I0 & 1)>(vb); R##I1 = tr_read<v_rd_off(D0, I1 >> 1, I1 & 1)>(vb); } while (0)
#define WAITL(N) asm volatile("s_waitcnt lgkmcnt(" #N ")" ::: "memory")
    if constexpr (DO_PV) TRL(a, 0, 0, 1, 2, 3);
    if constexpr (DO_QT) c0 = __builtin_amdgcn_mfma_f32_32x32x16_bf16(kc[0][0], qr[2], c0, 0, 0, 0);
    SBAR();
    if constexpr (DO_PV) TRL(a, 0, 4, 5, 6, 7);
    if constexpr (DO_QT) c1 = __builtin_amdgcn_mfma_f32_32x32x16_bf16(kc[0][1], qr[2], c1, 0, 0, 0);
    SBAR();
    if constexpr (DO_PV) TRL(b, 1, 0, 1, 2, 3);
    if constexpr (DK) __builtin_amdgcn_global_load_lds((const unsigned*)(kg + koff), (LAS unsigned*)kd, 16, 0, 0);
    if constexpr (DO_QT) c0 = __builtin_amdgcn_mfma_f32_32x32x16_bf16(kc[1][0], qr[3], c0, 0, 0, 0);
    SBAR();
    if constexpr (DO_PV) TRL(b, 1, 4, 5, 6, 7);
    if constexpr (DO_QT) c1 = __builtin_amdgcn_mfma_f32_32x32x16_bf16(kc[1][1], qr[3], c1, 0, 0, 0);
    SBAR();
    if constexpr (DO_PV) { WAITL(14); SBAR(); MMO(o[0], po0, a0, a1); TR2(a, 2, 0, 1); } SBAR();
    if constexpr (DO_PV) { WAITL(14); SBAR(); MMO(o[0], po1, a2, a3); TR2(a, 2, 2, 3); } SBAR();
    if constexpr (DK) __builtin_amdgcn_global_load_lds((const unsigned*)(kg + 4 * 128 + (koff ^ 32u)), (LAS unsigned*)(kd + 1024), 16, 0, 0);
    if constexpr (DO_PV) { WAITL(14); SBAR(); MMO(o[0], po2, a4, a5); TR2(a, 2, 4, 5); } SBAR();
    if constexpr (DO_PV) { WAITL(14); SBAR(); MMO(o[0], po3, a6, a7); TR2(a, 2, 6, 7); } SBAR();
    if constexpr (DO_PV) { WAITL(14); SBAR(); MMO(o[1], po0, b0, b1); TR2(b, 3, 0, 1); }
    if constexpr (DO_SM) { EX(c0, 0); EX(c0, 1); EX(c0, 2); } SBAR();
    if constexpr (DO_PV) { WAITL(14); SBAR(); MMO(o[1], po1, b2, b3); TR2(b, 3, 2, 3); }
    if constexpr (DO_SM) { EX(c0, 3); EX(c0, 4); EX(c0, 5); AD(c0, 0); AD(c0, 1); AD(c0, 2); } SBAR();
    if constexpr (DV) __builtin_amdgcn_global_load_lds((const unsigned*)(vg + voff), (LAS unsigned*)vd, 16, 0, 0);
    if constexpr (DO_PV) { WAITL(14); SBAR(); MMO(o[1], po2, b4, b5); TR2(b, 3, 4, 5); }
    if constexpr (DO_SM) { EX(c0, 6); EX(c0, 7); EX(c0, 8); AD(c0, 3); AD(c0, 4); AD(c0, 5); } SBAR();
    if constexpr (DO_PV) { WAITL(14); SBAR(); MMO(o[1], po3, b6, b7); TR2(b, 3, 6, 7); }
    if constexpr (DO_SM) { EX(c0, 9); EX(c0, 10); EX(c0, 11); AD(c0, 6); AD(c0, 7); AD(c0, 8); }
    SBAR();
    if constexpr (DO_PV) { WAITL(14); SBAR(); MMO(o[2], po0, a0, a1); }
    if constexpr (DO_SM) { EX(c0, 12); EX(c0, 13); EX(c0, 14); AD(c0, 9); AD(c0, 10); AD(c0, 11); } SBAR();
    if constexpr (DO_PV) { WAITL(12); SBAR(); MMO(o[2], po1, a2, a3); }
    if constexpr (DO_SM) { EX(c0, 15); EX(c1, 0); EX(c1, 1); AD(c0, 12); AD(c0, 13); AD(c0, 14); } SBAR();
    if constexpr (DV) __builtin_amdgcn_global_load_lds((const unsigned*)(vg + 64 + voff), (LAS unsigned*)(vd + 1024), 16, 0, 0);
    if constexpr (DO_PV) { WAITL(10); SBAR(); MMO(o[2], po2, a4, a5); }
    if constexpr (DO_SM) { EX(c1, 2); EX(c1, 3); EX(c1, 4); AD(c0, 15); AD(c1, 0); AD(c1, 1); } SBAR();
    if constexpr (DO_PV) { WAITL(8); SBAR(); MMO(o[2], po3, a6, a7); }
    if constexpr (DO_SM) { EX(c1, 5); EX(c1, 6); EX(c1, 7); AD(c1, 2); AD(c1, 3); AD(c1, 4); }
    SBAR();
    if constexpr (DO_PV) { WAITL(6); SBAR(); MMO(o[3], po0, b0, b1); }
    if constexpr (DO_QK) KLD(kf[0], 0);
    if constexpr (DO_SM) { EX(c1, 8); EX(c1, 9); EX(c1, 10); AD(c1, 5); AD(c1, 6); AD(c1, 7); CV(w0, 0, c0, 0); CV(w0, 1, c0, 2); } SBAR();
    if constexpr (DO_PV) { WAITL(4); SBAR(); MMO(o[3], po1, b2, b3); }
    if constexpr (DO_QK) KLD(kf[1], 1);
    if constexpr (DO_SM) { EX(c1, 11); EX(c1, 12); EX(c1, 13); AD(c1, 8); AD(c1, 9); AD(c1, 10); CV(w0, 2, c0, 4); CV(w0, 3, c0, 6); } SBAR();
    if constexpr (DO_PV) { WAITL(2); SBAR(); MMO(o[3], po2, b4, b5); }
    if constexpr (DO_SM) { EX(c1, 14); EX(c1, 15); AD(c1, 11); AD(c1, 12); AD(c1, 13); CV(w1, 0, c0, 8); CV(w1, 1, c0, 10); } SBAR();
    if constexpr (DO_PV) { WAITL(0); SBAR(); MMO(o[3], po3, b6, b7); }
    if constexpr (DO_SM) { AD(c1, 14); AD(c1, 15); CV(w1, 2, c0, 12); CV(w1, 3, c0, 14); } SBAR();
    if constexpr (DO_QK) {
#pragma unroll
        for (int r = 0; r < 16; ++r) { n0[r] = negm; n1[r] = negm; }
        KLD(kc[0], 2); n0 = __builtin_amdgcn_mfma_f32_32x32x16_bf16(kf[0][0], qr[0], n0, 0, 0, 0); }
    if constexpr (DO_SM) { CV(w2, 0, c1, 0); CV(w2, 1, c1, 2); } SBAR();
    if constexpr (DO_QK) { KLD(kc[1], 3); n1 = __builtin_amdgcn_mfma_f32_32x32x16_bf16(kf[0][1], qr[0], n1, 0, 0, 0); }
    if constexpr (DO_SM) { CV(w2, 2, c1, 4); CV(w2, 3, c1, 6); } SBAR();
    if constexpr (DO_QK) n0 = __builtin_amdgcn_mfma_f32_32x32x16_bf16(kf[1][0], qr[1], n0, 0, 0, 0);
    if constexpr (DO_SM) { CV(w3, 0, c1, 8); CV(w3, 1, c1, 10); } SBAR();
    if constexpr (DO_QK) n1 = __builtin_amdgcn_mfma_f32_32x32x16_bf16(kf[1][1], qr[1], n1, 0, 0, 0);
    if constexpr (DO_SM) { CV(w3, 2, c1, 12); CV(w3, 3, c1, 14); }
    if constexpr (DO_SM) { u32x4 t0 = {w0[0], w0[1], w0[2], w0[3]}, t1 = {w1[0], w1[1], w1[2], w1[3]}, t2 = {w2[0], w2[1], w2[2], w2[3]}, t3 = {w3[0], w3[1], w3[2], w3[3]};
        pn0 = *reinterpret_cast<bf16x8*>(&t0); pn1 = *reinterpret_cast<bf16x8*>(&t1); pn2 = *reinterpret_cast<bf16x8*>(&t2); pn3 = *reinterpret_cast<bf16x8*>(&t3); }
    SBAR();
}

__device__ __forceinline__ void attn_unit(const Params& p, int grp, int bh, int q0, char* lds) {
    const bf16_t* __restrict__ Qh; const bf16_t* __restrict__ Kh; const bf16_t* __restrict__ Vh; const float* __restrict__ k2;
    { const size_t ho = (size_t)bh * SEQ * 128;
      Qh = (const bf16_t*)((const unsigned char*)p.out + DO_BQ) + ho; Kh = (const bf16_t*)((const unsigned char*)p.out + DO_BK) + ho; Vh = (const bf16_t*)(p.ws + WS_BV) + ho;
      k2 = (const float*)(p.ws + WS_KMAX) + ((size_t)grp * NG * 8 + bh) * 2; }
    constexpr int LDK = 128;
    const int tid = opaque_tid(), wid = tid >> 6, lane = tid & 63, r32 = lane & 31, hi = lane >> 5, g = wid >> 2, wq = wid & 3;
    char* V_lds = lds; char* K_lds = lds + 2 * SHM_V;
    f32x16 o[4] = {}; float ls[4] = {0.f, 0.f, 0.f, 0.f}; bf16x8 qr[4];
    const bf16_t* Qw = Qh + (size_t)(q0 + wq * 32 + r32) * 128 + g * 64 + hi * 8;
#pragma unroll
    for (int d0 = 0; d0 < 4; ++d0) qr[d0] = *reinterpret_cast<const bf16x8*>(Qw + d0 * 16);
    float negm;
    { float ss = 0.f;
#pragma unroll
      for (int d0 = 0; d0 < 4; ++d0)
#pragma unroll
          for (int e = 0; e < 8; ++e) { const float q = bf2f((unsigned short)qr[d0][e]); ss = fmaf(q, q, ss); }
      auto rr = __builtin_amdgcn_permlane32_swap(__float_as_uint(ss), __float_as_uint(ss), false, false);
      ss = __uint_as_float(rr[0]) + __uint_as_float(rr[1]);
      negm = -sqrtf(ss * k2[g]); }
    const int vb0 = (int)(uintptr_t)V_lds + v_rd_base(lane);
    const int widu = __builtin_amdgcn_readfirstlane(wid);
    unsigned koff, voff;
    { const int a = widu * 2048 + lane * 16;
      const int row = a >> 8, colB = (a & 255) ^ ((row & 7) << 4); koff = (unsigned)(row * LDK + (colB >> 1));
      const int sub = a >> 9, kk = (sub >> 2) * 8 + ((a & 511) >> 6), k = kk, c = (sub & 3) * 32 + ((a & 63) >> 1); voff = (unsigned)(k * LDK + c); }
#define DMA_K(slot, k0) do { __builtin_amdgcn_global_load_lds((const unsigned*)(Kh + (size_t)(k0) * LDK + koff), (LAS unsigned*)(K_lds + (slot) * SHM_K + widu * 2048), 16, 0, 0); \
    __builtin_amdgcn_global_load_lds((const unsigned*)(Kh + (size_t)(k0) * LDK + 4 * LDK + (koff ^ 32u)), (LAS unsigned*)(K_lds + (slot) * SHM_K + widu * 2048 + 1024), 16, 0, 0); } while (0)
#define DMA_V(slot, k0) do { __builtin_amdgcn_global_load_lds((const unsigned*)(Vh + (size_t)(k0) * LDK + voff), (LAS unsigned*)(V_lds + (slot) * SHM_V + widu * 2048), 16, 0, 0); \
    __builtin_amdgcn_global_load_lds((const unsigned*)(Vh + (size_t)(k0) * LDK + 64 + voff), (LAS unsigned*)(V_lds + (slot) * SHM_V + widu * 2048 + 1024), 16, 0, 0); } while (0)
#define SWAIT() asm volatile("s_waitcnt vmcnt(0)" ::: "memory")
    f32x16 sA0, sA1, sB0, sB1; bf16x8 pX0, pX1, pX2, pX3, pY0, pY1, pY2, pY3; constexpr int NT = SEQ / KVBLK;
#define STEP(QT, QK, SM, PV, DK, DV, KT, VT, VS, KS, C0, C1, N0, N1, PO, PN) step3<QT, QK, SM, PV, DK, DV>(kc, Kh + (size_t)(KT) * (KVBLK * LDK), Vh + (size_t)(VT) * (KVBLK * LDK), \
        K_lds + ((KT) & 1) * SHM_K + widu * 2048, V_lds + ((VT) & 1) * SHM_V + widu * 2048, koff, voff, o, ls, vb0 + (VS) * SHM_V, K_lds + (KS) * SHM_K, qr, negm, g, r32, hi, C0, C1, N0, N1, PO##0, PO##1, PO##2, PO##3, PN##0, PN##1, PN##2, PN##3)
    bf16x8 kc[2][2];
    DMA_K(0, 0); DMA_K(1, KVBLK); DMA_V(0, 0); SWAIT(); __syncthreads();
    STEP(false, true, false, false, false, false, 0, 0, 0, 0, sB0, sB1, sA0, sA1, pY, pX);
    __syncthreads();
    DMA_K(0, 2 * KVBLK);
    STEP(true, true, true, false, false, false, 0, 0, 0, 1, sA0, sA1, sB0, sB1, pY, pX);
    SWAIT(); __syncthreads();
    for (int n = 1; n + 1 < NT; n += 2) {
        STEP(true, true, true, true, true, true, n + 2, n, 0, 0, sB0, sB1, sA0, sA1, pX, pY);
        SWAIT(); __syncthreads();
        const int kt = n + 3 < NT ? n + 3 : NT - 2;
        STEP(true, true, true, true, true, true, kt, n + 1, 1, 1, sA0, sA1, sB0, sB1, pY, pX);
        SWAIT(); __syncthreads();
    }
    STEP(true, false, true, true, false, true, 0, NT - 1, 0, 0, sB0, sB1, sA0, sA1, pX, pY);
    SWAIT(); __syncthreads();
    STEP(false, false, false, true, false, false, 0, 0, 1, 0, sA0, sA1, sB0, sB1, pY, pX);
    int bh2 = bh; asm volatile("" : "+s"(bh2));
    const bf16_t* __restrict__ Zh = (const bf16_t*)(p.ws + WS_SBZ) + (size_t)bh2 * SEQ * 128;
    bf16_t* __restrict__ Yrow0 = (bf16_t*)(p.ws + WS_YB) + (size_t)(bh2 >> 3) * SEQ * 1024 + (bh2 & 7) * 128;
    const float* __restrict__ subg = p.da_subln_g; const float* __restrict__ lamp = (const float*)(p.ws + WS_MISC);
    float rli[16];
    { float lt = (ls[0] + ls[1]) + (ls[2] + ls[3]);
      auto rr = __builtin_amdgcn_permlane32_swap(__float_as_uint(lt), __float_as_uint(lt), false, false);
      lt = __builtin_amdgcn_rcpf(__uint_as_float(rr[0]) + __uint_as_float(rr[1]));
#pragma unroll
      for (int r = 0; r < 16; ++r) rli[r] = __uint_as_float((unsigned)__builtin_amdgcn_ds_bpermute(crow(r, hi) * 4, (int)__float_as_uint(lt))); }
    __syncthreads();
    float* X = (float*)lds;
    if (g == 1) {
        const float lam = *lamp;
#pragma unroll
        for (int d0 = 0; d0 < 4; ++d0)
#pragma unroll
            for (int r = 0; r < 16; ++r) X[((wq * 4 + d0) * 16 + r) * 64 + lane] = o[d0][r] * rli[r] * lam;
    }
    __syncthreads();
    if (g == 0) {
        float ss[16];
#pragma unroll
        for (int r = 0; r < 16; ++r) { float a = 0.f;
#pragma unroll
            for (int d0 = 0; d0 < 4; ++d0) { const float v = o[d0][r] * rli[r] - X[((wq * 4 + d0) * 16 + r) * 64 + lane]; o[d0][r] = v; a += v * v; }
            ss[r] = a; }
#pragma unroll
        for (int r = 0; r < 16; ++r) {
#pragma unroll
            for (int off = 1; off < 32; off <<= 1) ss[r] += SHX(ss[r], off);
        }
        float sg[4];
#pragma unroll
        for (int d0 = 0; d0 < 4; ++d0) sg[d0] = subg[32 * d0 + r32] * 0.8f;
        float* Yt = (float*)(lds + 69632);
#pragma unroll
        for (int r = 0; r < 16; ++r) {
            const float rs = rsqrtf(ss[r] * (1.f / 128.f) + 1e-6f);
            const int lrow = wq * 32 + crow(r, hi);
#pragma unroll
            for (int d0 = 0; d0 < 4; ++d0) Yt[lrow * 128 + 32 * d0 + r32] = o[d0][r] * rs * sg[d0];
        }
    }
    __syncthreads();
    {
        const float* Yt = (const float*)(lds + 69632);
        const int tid3 = opaque_tid();
#pragma unroll
        for (int i = 0; i < 4; ++i) {
            const int e = tid3 + 512 * i, lrow = e >> 4, c8 = (e & 15) * 8;
            const size_t qrow = (size_t)(q0 + lrow);
            const bf16x8 z = *(const bf16x8*)(Zh + qrow * 128 + c8);
            const f32x4 y0 = *(const f32x4*)(Yt + lrow * 128 + c8), y1 = *(const f32x4*)(Yt + lrow * 128 + c8 + 4);
            u32x4 pk;
            pk.x = pg8::cvt_pk_bf16(y0[0] * bf2f((unsigned short)z[0]), y0[1] * bf2f((unsigned short)z[1])); pk.y = pg8::cvt_pk_bf16(y0[2] * bf2f((unsigned short)z[2]), y0[3] * bf2f((unsigned short)z[3]));
            pk.z = pg8::cvt_pk_bf16(y1[0] * bf2f((unsigned short)z[4]), y1[1] * bf2f((unsigned short)z[5])); pk.w = pg8::cvt_pk_bf16(y1[2] * bf2f((unsigned short)z[6]), y1[3] * bf2f((unsigned short)z[7]));
            *(u32x4*)(Yrow0 + qrow * 1024 + c8) = pk;
        }
    }
    __syncthreads();
#undef DMA_K
#undef DMA_V
#undef SWAIT
#undef STEP
}
}

__device__ __forceinline__ void phase_attention(const Params& p, char* lds, int grp) {
    const int G = gridDim.x, vcu = vcu_of(blockIdx.x, G);
    for (int it = vcu; it < NG * 8 * 64; it += G) att::attn_unit(p, grp, it >> 6, (it & 63) * 128, lds);
}

namespace ml {
constexpr int GT_A = 0, GT_B = 1, GT_MR = 2;
constexpr int GC_BLAST = 0, GC_AMAX = 1, GC_MST = 2, GC_DECAY = 3, GC_GAIN = 4;
__device__ __forceinline__ float* gtok(unsigned char* ws, int gch, int row) { return (float*)(ws + WS_GTOK) + ((size_t)gch * 3 + row) * SEQ; }
__device__ __forceinline__ float* gch_(unsigned char* ws, int gch, int row) { return (float*)(ws + WS_GCH) + ((size_t)gch * 8 + row) * NCH; }
constexpr float ST_SC = 16.f, ST_ISC = 0.0625f, ST_MAX = 448.f;
__device__ __forceinline__ unsigned char* state_ptr(const Params& p, int grp, int ch, int c) {
    const int bl = ch >> 3, dir = (ch >> 2) & 1, h = ch & 3, li = bl * 4 + h;
    unsigned char* base = dir ? p.ws + WS_HBF + (size_t)grp * TG * DM * 2 : p.ws + WS_STF;
    return base + ((size_t)li * NCH + c) * 65536;
}
__device__ __forceinline__ float st_clamp(float x) { return fminf(fmaxf(x * ST_SC, -ST_MAX), ST_MAX); }
__device__ __forceinline__ unsigned st_pack4(float a, float b, float c, float d) {
    int w = __builtin_amdgcn_cvt_pk_fp8_f32(st_clamp(a), st_clamp(b), 0, false);
    w = __builtin_amdgcn_cvt_pk_fp8_f32(st_clamp(c), st_clamp(d), w, true);
    return (unsigned)w;
}
__device__ __forceinline__ float* nstate_ptr(const Params& p, int gch, int c) { return (float*)(p.ws + WS_NST) + ((size_t)gch * NCH + c) * 256; }

__device__ __forceinline__ void phase_gateprep(const Params& p, int grp) {
    const int tid = opaque_tid(), lane = tid & 63, wave = tid >> 6;
    for (int it = blockIdx.x * NWAVES + wave; it < NG * 8 * NCH; it += gridDim.x * NWAVES) {
        const int ch = it >> 6, c = it & 63;
        const int bl = ch >> 3, dir = (ch >> 2) & 1, h = ch & 3, gch = grp * NG * 8 + ch, b = grp * NG + bl;
        const float* gates = (const float*)(p.ws + WS_GATE) + (size_t)b * SEQ * 16;
        const int ci = (2 * dir) * 4 + h, cf = (2 * dir + 1) * 4 + h;
        const float bi = p.ml_gate_b[ci], bf = p.ml_gate_b[cf];
        float* A = gtok(p.ws, gch, GT_A); float* B = gtok(p.ws, gch, GT_B); float* MR = gtok(p.ws, gch, GT_MR);
        float iv[2], lf[2];
#pragma unroll
        for (int q = 0; q < 2; ++q) {
            const int pp = c * CH + 2 * lane + q, s = dir ? SEQ - 1 - pp : pp;
            iv[q] = gates[(size_t)s * 16 + ci] + bi;
            const float f = gates[(size_t)s * 16 + cf] + bf;
            lf[q] = fminf(f, 0.f) - log1pf(expf(-fabsf(f)));
        }
        float tot = lf[0] + lf[1], inc = tot;
#pragma unroll
        for (int off = 1; off < 64; off <<= 1) { const float v = SHUP(inc, off); if (lane >= off) inc += v; }
        const float ex = inc - tot;
        const float b0 = ex + lf[0], b1 = ex + lf[0] + lf[1];
        const float a0 = iv[0] - b0, a1 = iv[1] - b1;
        float mx = fmaxf(a0, a1), minc = mx;
#pragma unroll
        for (int off = 1; off < 64; off <<= 1) { const float v = SHUP(minc, off); if (lane >= off) minc = fmaxf(minc, v); }
        float mex = SHUP(minc, 1); if (lane == 0) mex = -INFINITY;
        const float pm0 = fmaxf(mex, a0), pm1 = fmaxf(pm0, a1);
        const int p0 = c * CH + 2 * lane;
        A[p0] = a0; A[p0 + 1] = a1; B[p0] = b0; B[p0 + 1] = b1; MR[p0] = b0 + pm0; MR[p0 + 1] = b1 + pm1;
        if (lane == 63) { gch_(p.ws, gch, GC_BLAST)[c] = b1; gch_(p.ws, gch, GC_AMAX)[c] = pm1; }
    }
}
__device__ __forceinline__ void phase_gatescan(const Params& p, LAS unsigned char* lds, int grp) {
    const int tid = opaque_tid();
    LAS float* sb = (LAS float*)lds;
    for (int ch = blockIdx.x; ch < NG * 8; ch += gridDim.x) {
        const int gch = grp * NG * 8 + ch;
        if (tid < NCH) { sb[tid] = gch_(p.ws, gch, GC_BLAST)[tid]; sb[NCH + tid] = gch_(p.ws, gch, GC_AMAX)[tid]; }
        __syncthreads();
        if (tid == 0) {
            float* MS = gch_(p.ws, gch, GC_MST); float* DE = gch_(p.ws, gch, GC_DECAY); float* GA = gch_(p.ws, gch, GC_GAIN);
            float mprev = 0.f;
            for (int c = 0; c < NCH; ++c) {
                const float bl_ = sb[c], am = sb[NCH + c], mloc = bl_ + am, mnew = fmaxf(bl_ + mprev, mloc);
                MS[c] = mprev; DE[c] = expf(bl_ + mprev - mnew); GA[c] = expf(mloc - mnew);
                mprev = mnew;
            }
        }
        __syncthreads();
    }
}

constexpr int TS = 528;
constexpr int TILE_B = 128 * TS;
constexpr int PS = 272;
constexpr int CS_ = 144, CBUF = 256 * CS_;
constexpr int R0 = 0, R1 = TILE_B, R1_B = 2 * CBUF;
constexpr int SC0 = R1 + R1_B;
static_assert(SC0 + 3328 * 4 <= LDS_BYTES, "mLSTM LDS map");

__device__ __forceinline__ void stage_conv(const bf16_t* __restrict__ src, int s0, const float* __restrict__ cw  ,
                                           float scale, LAS unsigned char* dst) {
    const int tid = opaque_tid(), cg = tid & 31, rg = tid >> 5;
    float w[5][8];
#pragma unroll
    for (int j = 0; j < 5; ++j) { const f32x4 w0 = *(const f32x4*)(cw + j * 2048 + cg * 8), w1 = *(const f32x4*)(cw + j * 2048 + cg * 8 + 4);
        w[j][0] = w0[0]; w[j][1] = w0[1]; w[j][2] = w0[2]; w[j][3] = w0[3]; w[j][4] = w1[0]; w[j][5] = w1[1]; w[j][6] = w1[2]; w[j][7] = w1[3]; }
    const bf16x8 zero8 = {0, 0, 0, 0, 0, 0, 0, 0};
    const int sb = s0 + rg * 8 - 2;
    bf16x8 in[12];
#pragma unroll
    for (int i = 0; i < 12; ++i) { const int s = sb + i; in[i] = (s >= 0 && s < SEQ) ? *(const bf16x8*)(src + (size_t)s * 256 + cg * 8) : zero8; }
#pragma unroll
    for (int r = 0; r < 8; ++r) {
        float o[8];
#pragma unroll
        for (int e = 0; e < 8; ++e) {
            float a = w[0][e] * bf2f((unsigned short)in[r][e]);
            a = fmaf(w[1][e], bf2f((unsigned short)in[r + 1][e]), a); a = fmaf(w[2][e], bf2f((unsigned short)in[r + 2][e]), a);
            a = fmaf(w[3][e], bf2f((unsigned short)in[r + 3][e]), a); a = fmaf(w[4][e], bf2f((unsigned short)in[r + 4][e]), a);
            o[e] = fast_silu(a) * scale; }
        u32x4 pk; pk.x = pg8::cvt_pk_bf16(o[0], o[1]); pk.y = pg8::cvt_pk_bf16(o[2], o[3]); pk.z = pg8::cvt_pk_bf16(o[4], o[5]); pk.w = pg8::cvt_pk_bf16(o[6], o[7]);
        *(LAS u32x4*)(dst + (rg * 8 + r) * TS + cg * 16) = pk;
    }
}
__device__ __forceinline__ void stage_rows(const bf16_t* __restrict__ src, int s0, const LAS float* wrow, LAS unsigned char* dst) {
    const int tid = opaque_tid(), cg = tid & 31, rg = tid >> 5;
#pragma unroll
    for (int r = 0; r < 8; ++r) {
        const int row = rg * 8 + r;
        bf16x8 v = *(const bf16x8*)(src + (size_t)(s0 + row) * 256 + cg * 8);
        if (wrow) { const float w = wrow[row]; u32x4 pk;
            pk.x = pg8::cvt_pk_bf16(bf2f((unsigned short)v[0]) * w, bf2f((unsigned short)v[1]) * w); pk.y = pg8::cvt_pk_bf16(bf2f((unsigned short)v[2]) * w, bf2f((unsigned short)v[3]) * w);
            pk.z = pg8::cvt_pk_bf16(bf2f((unsigned short)v[4]) * w, bf2f((unsigned short)v[5]) * w); pk.w = pg8::cvt_pk_bf16(bf2f((unsigned short)v[6]) * w, bf2f((unsigned short)v[7]) * w);
            *(LAS u32x4*)(dst + row * TS + cg * 16) = pk; }
        else *(LAS bf16x8*)(dst + row * TS + cg * 16) = v;
    }
}
__device__ __forceinline__ bf16x8 frag_tr(const LAS unsigned char* tile, int stride, int k0, int n0, int lane) {
    const int g = lane >> 4, i = lane & 15, q = i >> 2, pp = i & 3;
    const LAS unsigned char* a = tile + (k0 + 8 * g + q) * stride + (n0 + 4 * pp) * 2;
    typedef short v4i16_t __attribute__((ext_vector_type(4)));
    const s16x4 lo = __builtin_bit_cast(s16x4, __builtin_amdgcn_ds_read_tr16_b64_v4i16((LAS v4i16_t*)a));
    const s16x4 hi = __builtin_bit_cast(s16x4, __builtin_amdgcn_ds_read_tr16_b64_v4i16((LAS v4i16_t*)(a + 4 * stride)));
    return (bf16x8){lo[0], lo[1], lo[2], lo[3], hi[0], hi[1], hi[2], hi[3]};
}
__device__ __forceinline__ bf16x8 frag_row(const LAS unsigned char* tile, int stride, int n0, int k0, int lane) {
    return *(const LAS bf16x8*)(tile + (n0 + (lane & 15)) * stride + (k0 + 8 * (lane >> 4)) * 2);
}

__device__ __forceinline__ void mlocal_item(const Params& p, LAS unsigned char* lds, int grp, int ch, int c) {
    int tid_ = threadIdx.x; asm volatile("" : "+v"(tid_));
    const int tid = tid_, lane = tid & 63, wave = tid >> 6, wr = wave >> 2, wc = wave & 3;
    const int bl = ch >> 3, dir = (ch >> 2) & 1, h = ch & 3, gch = grp * NG * 8 + ch;
    const int oc = dir ? NCH - 1 - c : c, s0 = oc * CH;
    LAS float* wrow = (LAS float*)(lds + SC0);
    __syncthreads();
    if (tid < CH) { const int j = dir ? CH - 1 - tid : tid;
        wrow[tid] = fast_exp(gtok(p.ws, gch, GT_A)[c * CH + j] - gch_(p.ws, gch, GC_AMAX)[c]); }
    const bf16_t* AKh = (const bf16_t*)(p.ws + WS_AK) + (size_t)(bl * 4 + h) * SEQ * 256;
    const bf16_t* AVh = (const bf16_t*)(p.ws + WS_AV) + (size_t)(bl * 4 + h) * SEQ * 256;
    bf16x8 vpre[8];
    { const int cg = tid & 31, rg = tid >> 5;
#pragma unroll
      for (int r = 0; r < 8; ++r) vpre[r] = *(const bf16x8*)(AVh + (size_t)(s0 + rg * 8 + r) * 256 + cg * 8); }
    stage_conv(AKh, s0, p.ml_conv_w + 1024 + h * 256, 0.0625f, lds + R1);
    __syncthreads();
    { const int cg = tid & 31, rg = tid >> 5;
#pragma unroll
      for (int r = 0; r < 8; ++r) { const int row = rg * 8 + r; const float w = wrow[row]; const bf16x8 v = vpre[r]; u32x4 pk;
        pk.x = pg8::cvt_pk_bf16(bf2f((unsigned short)v[0]) * w, bf2f((unsigned short)v[1]) * w); pk.y = pg8::cvt_pk_bf16(bf2f((unsigned short)v[2]) * w, bf2f((unsigned short)v[3]) * w);
        pk.z = pg8::cvt_pk_bf16(bf2f((unsigned short)v[4]) * w, bf2f((unsigned short)v[5]) * w); pk.w = pg8::cvt_pk_bf16(bf2f((unsigned short)v[6]) * w, bf2f((unsigned short)v[7]) * w);
        *(LAS u32x4*)(lds + R0 + row * TS + cg * 16) = pk; } }
    __syncthreads();
    if (tid < 256) { float a0 = 0.f, a1 = 0.f, a2 = 0.f, a3 = 0.f;
#pragma unroll 2
        for (int s = 0; s < CH; s += 8) {
            float kv[8];
#pragma unroll
            for (int u = 0; u < 8; ++u) kv[u] = bf2f(*(const LAS unsigned short*)(lds + R1 + (s + u) * TS + tid * 2));
            const f32x4 w0 = *(const LAS f32x4*)(wrow + s), w1 = *(const LAS f32x4*)(wrow + s + 4);
            a0 = fmaf(w0[0], kv[0], a0); a1 = fmaf(w0[1], kv[1], a1); a2 = fmaf(w0[2], kv[2], a2); a3 = fmaf(w0[3], kv[3], a3);
            a0 = fmaf(w1[0], kv[4], a0); a1 = fmaf(w1[1], kv[5], a1); a2 = fmaf(w1[2], kv[6], a2); a3 = fmaf(w1[3], kv[7], a3);
        }
        nstate_ptr(p, gch, c)[tid] = (a0 + a1) + (a2 + a3); }
    f32x4 acc[8][4];
#pragma unroll
    for (int i = 0; i < 8; ++i)
#pragma unroll
        for (int j = 0; j < 4; ++j) acc[i][j] = (f32x4){0.f, 0.f, 0.f, 0.f};
#pragma unroll 1
    for (int ks = 0; ks < 4; ++ks) {
        bf16x8 bfr[4];
#pragma unroll
        for (int j = 0; j < 4; ++j) bfr[j] = frag_tr(lds + R0, TS, ks * 32, wc * 64 + j * 16, lane);
#pragma unroll
        for (int i = 0; i < 8; ++i) { const bf16x8 afr = frag_tr(lds + R1, TS, ks * 32, wr * 128 + i * 16, lane);
#pragma unroll
            for (int j = 0; j < 4; ++j) acc[i][j] = __builtin_amdgcn_mfma_f32_16x16x32_bf16(afr, bfr[j], acc[i][j], 0, 0, 0); }
    }
    __syncthreads();
    const int fr = lane & 15, fq = lane >> 4;
#pragma unroll
    for (int i = 0; i < 8; ++i)
#pragma unroll
        for (int j = 0; j < 4; ++j) { const int dv = wc * 64 + j * 16 + fr, dk = wr * 128 + i * 16 + 4 * fq;
            *(LAS unsigned*)(lds + dv * 272 + dk) = st_pack4(acc[i][j][0], acc[i][j][1], acc[i][j][2], acc[i][j][3]); }
    __syncthreads();
    unsigned char* C = state_ptr(p, grp, ch, c);
#pragma unroll
    for (int i = 0; i < 8; ++i) { const int e = tid + 512 * i, row = e >> 4, c16 = e & 15;
        *(u32x4*)(C + (size_t)row * 256 + c16 * 16) = *(const LAS u32x4*)(lds + row * 272 + c16 * 16); }
}
__device__ __forceinline__ void phase_mlocal(const Params& p, LAS unsigned char* lds, int grp) {
    for (int it = blockIdx.x; it < NG * 8 * NCH; it += gridDim.x) mlocal_item(p, lds, grp, it >> 6, it & 63);
}

__device__ __forceinline__ void phase_mscan(const Params& p, int grp) {
    const int gt = blockIdx.x * NTHR + opaque_tid(), NT = gridDim.x * NTHR;
    for (int v = gt; v < NG * 8 * 8192; v += NT) {
        const int ch = v >> 13, vec = v & 8191, gch = grp * NG * 8 + ch;
        const float* DE = gch_(p.ws, gch, GC_DECAY); const float* GA = gch_(p.ws, gch, GC_GAIN);
        unsigned char* base = state_ptr(p, grp, ch, 0) + (size_t)vec * 8;
        float acc[8];
#pragma unroll
        for (int e = 0; e < 8; ++e) acc[e] = 0.f;
        for (int c0 = 0; c0 < NCH; c0 += 4) {
            u32x2 d[4];
#pragma unroll
            for (int u = 0; u < 4; ++u) d[u] = *(const u32x2*)(base + (size_t)(c0 + u) * 65536);
#pragma unroll
            for (int u = 0; u < 4; ++u) {
                const float de = DE[c0 + u], ga = GA[c0 + u] * ST_ISC;
                u32x2 pk; pk.x = st_pack4(acc[0], acc[1], acc[2], acc[3]); pk.y = st_pack4(acc[4], acc[5], acc[6], acc[7]);
                *(u32x2*)(base + (size_t)(c0 + u) * 65536) = pk;
                const auto f0 = __builtin_amdgcn_cvt_pk_f32_fp8((int)d[u].x, false), f1 = __builtin_amdgcn_cvt_pk_f32_fp8((int)d[u].x, true);
                const auto f2 = __builtin_amdgcn_cvt_pk_f32_fp8((int)d[u].y, false), f3 = __builtin_amdgcn_cvt_pk_f32_fp8((int)d[u].y, true);
                acc[0] = de * acc[0] + ga * f0[0]; acc[1] = de * acc[1] + ga * f0[1]; acc[2] = de * acc[2] + ga * f1[0]; acc[3] = de * acc[3] + ga * f1[1];
                acc[4] = de * acc[4] + ga * f2[0]; acc[5] = de * acc[5] + ga * f2[1]; acc[6] = de * acc[6] + ga * f3[0]; acc[7] = de * acc[7] + ga * f3[1];
            }
        }
    }
    for (int v = gt; v < NG * 8 * 256; v += NT) {
        const int ch = v >> 8, dk = v & 255, gch = grp * NG * 8 + ch;
        const float* DE = gch_(p.ws, gch, GC_DECAY); const float* GA = gch_(p.ws, gch, GC_GAIN);
        float acc = 0.f;
        for (int c = 0; c < NCH; ++c) { float* q = nstate_ptr(p, gch, c) + dk; const float d = *q; *q = acc; acc = DE[c] * acc + GA[c] * d; }
    }
}

__device__ __forceinline__ void mout_item(const Params& p, LAS unsigned char* lds, int grp, int bl, int h, int oc) {
    int tid_ = threadIdx.x; asm volatile("" : "+v"(tid_));
    const int tid = tid_, lane = tid & 63, wave = tid >> 6, wr = wave >> 2, wc = wave & 3, fr = lane & 15, fq = lane >> 4;
    const int s0 = oc * CH, chf = (bl * 2 + 0) * 4 + h, chb = (bl * 2 + 1) * 4 + h, gf = grp * NG * 8 + chf, gb = grp * NG * 8 + chb, cb = NCH - 1 - oc;
    LAS float* SC = (LAS float*)(lds + SC0);
    LAS float* RT = SC;
    LAS float* SI = SC + 256;
    LAS float* EM = SC + 512;
    LAS float* AS = SC + 768;
    LAS float* NS = SC + 1024;
    LAS float* DENP = SC + 1536;
    LAS float* DENI = SC + 2560;
    LAS float* SS = SC + 2816;
    __syncthreads();
    if (tid < 256) {
        const int d = tid >> 7, t = tid & 127, g = d ? gb : gf, c = d ? cb : oc, pp = c * CH + (d ? CH - 1 - t : t);
        const float b = gtok(p.ws, g, GT_B)[pp], mr = gtok(p.ws, g, GT_MR)[pp], a = gtok(p.ws, g, GT_A)[pp], ms = gch_(p.ws, g, GC_MST)[c];
        const float m = fmaxf(b + ms, mr);
        RT[tid] = b - m; SI[tid] = fast_exp(b + ms - m); EM[tid] = fast_exp(-m); AS[tid] = a;
    } else {
        const int d = (tid - 256) >> 7, k2 = (tid - 256) & 127;
        const float* n = nstate_ptr(p, d ? gb : gf, d ? cb : oc);
        NS[d * 256 + 2 * k2] = n[2 * k2]; NS[d * 256 + 2 * k2 + 1] = n[2 * k2 + 1];
    }
    const bf16_t* AQh = (const bf16_t*)(p.ws + WS_AQ) + (size_t)(bl * 4 + h) * SEQ * 256;
    const bf16_t* AKh = (const bf16_t*)(p.ws + WS_AK) + (size_t)(bl * 4 + h) * SEQ * 256;
    const bf16_t* AVh = (const bf16_t*)(p.ws + WS_AV) + (size_t)(bl * 4 + h) * SEQ * 256;
    stage_conv(AQh, s0, p.ml_conv_w + h * 256, 1.f, lds + R0);
    asm volatile("" ::: "memory");
    stage_conv(AKh, s0, p.ml_conv_w + 1024 + h * 256, 0.0625f, lds + R1);
    __syncthreads();
    f32x4 sacc[2][4];
#pragma unroll
    for (int i = 0; i < 2; ++i)
#pragma unroll
        for (int j = 0; j < 4; ++j) sacc[i][j] = (f32x4){0.f, 0.f, 0.f, 0.f};
#pragma unroll
    for (int ks = 0; ks < 8; ++ks) {
        bf16x8 qf[4];
#pragma unroll
        for (int j = 0; j < 4; ++j) qf[j] = frag_row(lds + R0, TS, wr * 64 + j * 16, ks * 32, lane);
#pragma unroll
        for (int i = 0; i < 2; ++i) { const bf16x8 kf = frag_row(lds + R1, TS, wc * 32 + i * 16, ks * 32, lane);
#pragma unroll
            for (int j = 0; j < 4; ++j) sacc[i][j] = __builtin_amdgcn_mfma_f32_16x16x32_bf16(kf, qf[j], sacc[i][j], 0, 0, 0); }
    }
    {
        const int t = tid >> 2, qd = tid & 3; float df = 0.f, db = 0.f;
#pragma unroll
        for (int e8 = 0; e8 < 8; ++e8) { const bf16x8 qv = *(const LAS bf16x8*)(lds + R0 + t * TS + (qd * 64 + e8 * 8) * 2);
#pragma unroll
            for (int e = 0; e < 8; ++e) { const float q = bf2f((unsigned short)qv[e]); df = fmaf(q, NS[qd * 64 + e8 * 8 + e], df); db = fmaf(q, NS[256 + qd * 64 + e8 * 8 + e], db); } }
        df += SHX(df, 1); df += SHX(df, 2); db += SHX(db, 1); db += SHX(db, 2);
        if (qd == 0) { DENI[t] = df; DENI[128 + t] = db; }
    }
    __syncthreads();
    f32x4 acc[2][4][4];
    {
        const int e0 = tid;
        u32x4 cst[2];
#define C_SRC(s_) (state_ptr(p, grp, (s_) >= 4 ? chb : chf, (s_) >= 4 ? cb : oc) + ((s_) & 3) * 64)
#define C_LOAD(s_) do { const unsigned char* cs_ = C_SRC(s_); _Pragma("unroll") for (int i = 0; i < 2; ++i) { const int e = e0 + 512 * i; cst[i] = *(const u32x4*)(cs_ + (size_t)(e >> 2) * 256 + (e & 3) * 16); } } while (0)
#define C_CVT2(w_, lo_, hi_) do { const auto f0_ = __builtin_amdgcn_cvt_pk_f32_fp8((int)(w_), false), f1_ = __builtin_amdgcn_cvt_pk_f32_fp8((int)(w_), true); \
        lo_ = pg8::cvt_pk_bf16(f0_[0] * ST_ISC, f0_[1] * ST_ISC); hi_ = pg8::cvt_pk_bf16(f1_[0] * ST_ISC, f1_[1] * ST_ISC); } while (0)
#define C_WRITE(b_) do { _Pragma("unroll") for (int i = 0; i < 2; ++i) { const int e = e0 + 512 * i; u32x4 lo4, hi4; \
        C_CVT2(cst[i].x, lo4.x, lo4.y); C_CVT2(cst[i].y, lo4.z, lo4.w); C_CVT2(cst[i].z, hi4.x, hi4.y); C_CVT2(cst[i].w, hi4.z, hi4.w); \
        LAS unsigned char* d_ = lds + R1 + (b_) * CBUF + (e >> 2) * CS_ + (e & 3) * 32; *(LAS u32x4*)d_ = lo4; *(LAS u32x4*)(d_ + 16) = hi4; } } while (0)
        C_LOAD(0); C_WRITE(0);
        __syncthreads();
#pragma unroll
        for (int d = 0; d < 2; ++d) {
#pragma unroll
            for (int i = 0; i < 4; ++i)
#pragma unroll
                for (int j = 0; j < 4; ++j) acc[d][i][j] = (f32x4){0.f, 0.f, 0.f, 0.f};
#pragma unroll 1
            for (int q = 0; q < 4; ++q) {
                const int st = d * 4 + q;
                if (st < 7) C_LOAD(st + 1);
                const LAS unsigned char* cb_ = lds + R1 + (q & 1) * CBUF;
#pragma unroll
                for (int k2 = 0; k2 < 2; ++k2) {
                    bf16x8 cf[4], qf[4];
#pragma unroll
                    for (int i = 0; i < 4; ++i) cf[i] = frag_row(cb_, CS_, wc * 64 + i * 16, k2 * 32, lane);
#pragma unroll
                    for (int j = 0; j < 4; ++j) qf[j] = frag_row(lds + R0, TS, wr * 64 + j * 16, q * 64 + k2 * 32, lane);
#pragma unroll
                    for (int i = 0; i < 4; ++i)
#pragma unroll
                        for (int j = 0; j < 4; ++j) acc[d][i][j] = __builtin_amdgcn_mfma_f32_16x16x32_bf16(cf[i], qf[j], acc[d][i][j], 0, 0, 0);
                }
                if (st < 7) C_WRITE((q + 1) & 1);
                __syncthreads();
            }
#pragma unroll
            for (int j = 0; j < 4; ++j) { const float si = SI[d * 128 + wr * 64 + j * 16 + fr];
#pragma unroll
                for (int i = 0; i < 4; ++i) acc[d][i][j] = acc[d][i][j] * si; }
        }
#undef C_SRC
#undef C_LOAD
#undef C_CVT2
#undef C_WRITE
    }
    {
        LAS unsigned char* Pf = lds + R1; LAS unsigned char* Pb = lds + R1 + 128 * PS;
#pragma unroll
        for (int j = 0; j < 4; ++j) {
            const int t = wr * 64 + j * 16 + fr;
            const float rtf = RT[t], rtb = RT[128 + t];
            float sf = 0.f, sbw = 0.f;
#pragma unroll
            for (int i = 0; i < 2; ++i) {
                const int sb0 = wc * 32 + i * 16 + 4 * fq;
                float pf[4], pb[4];
#pragma unroll
                for (int r = 0; r < 4; ++r) { const int s = sb0 + r; const float sv = sacc[i][j][r];
                    pf[r] = (s <= t) ? sv * fast_exp(rtf + AS[s]) : 0.f;
                    pb[r] = (s >= t) ? sv * fast_exp(rtb + AS[128 + s]) : 0.f;
                    sf += pf[r]; sbw += pb[r]; }
                u32x2 a; a.x = pg8::cvt_pk_bf16(pf[0], pf[1]); a.y = pg8::cvt_pk_bf16(pf[2], pf[3]);
                u32x2 b; b.x = pg8::cvt_pk_bf16(pb[0], pb[1]); b.y = pg8::cvt_pk_bf16(pb[2], pb[3]);
                *(LAS u32x2*)(Pf + t * PS + sb0 * 2) = a; *(LAS u32x2*)(Pb + t * PS + sb0 * 2) = b;
            }
            sf += SHX(sf, 16); sf += SHX(sf, 32); sbw += SHX(sbw, 16); sbw += SHX(sbw, 32);
            if (fq == 0) { DENP[(0 * 4 + wc) * 128 + t] = sf; DENP[(1 * 4 + wc) * 128 + t] = sbw; }
        }
    }
    __syncthreads();
    stage_rows(AVh, s0, (const LAS float*)nullptr, lds + R0);
    __syncthreads();
#pragma unroll 1
    for (int ks = 0; ks < 4; ++ks) {
        bf16x8 vf[4];
#pragma unroll
        for (int i = 0; i < 4; ++i) vf[i] = frag_tr(lds + R0, TS, ks * 32, wc * 64 + i * 16, lane);
#pragma unroll
        for (int d = 0; d < 2; ++d) {
            const LAS unsigned char* P = lds + R1 + d * 128 * PS;
#pragma unroll
            for (int j = 0; j < 4; ++j) { const bf16x8 pf = frag_row(P, PS, wr * 64 + j * 16, ks * 32, lane);
#pragma unroll
                for (int i = 0; i < 4; ++i) acc[d][i][j] = __builtin_amdgcn_mfma_f32_16x16x32_bf16(vf[i], pf, acc[d][i][j], 0, 0, 0); }
        }
    }
    float ssq[4];
#pragma unroll
    for (int j = 0; j < 4; ++j) {
        const int t = wr * 64 + j * 16 + fr;
        float dn[2];
#pragma unroll
        for (int d = 0; d < 2; ++d) { const float den = (DENP[(d * 4 + 0) * 128 + t] + DENP[(d * 4 + 1) * 128 + t]) + (DENP[(d * 4 + 2) * 128 + t] + DENP[(d * 4 + 3) * 128 + t]) + SI[d * 128 + t] * DENI[d * 128 + t];
            dn[d] = __builtin_amdgcn_rcpf(fmaxf(fabsf(den), EM[d * 128 + t])); }
        float a = 0.f;
#pragma unroll
        for (int i = 0; i < 4; ++i) { const f32x4 hv = acc[0][i][j] * dn[0] + acc[1][i][j] * dn[1]; acc[0][i][j] = hv; a += (hv[0] * hv[0] + hv[1] * hv[1]) + (hv[2] * hv[2] + hv[3] * hv[3]); }
        a += SHX(a, 16); a += SHX(a, 32);
        ssq[j] = a;
        if (fq == 0) SS[wc * 128 + t] = a;
    }
    __syncthreads();
    const bf16_t* OZh = (const bf16_t*)(p.ws + WS_OZ) + ((size_t)(bl * 4 + h) * SEQ + s0) * 256;
    bf16_t* YA = (bf16_t*)(p.ws + WS_YA) + ((size_t)bl * SEQ + s0) * 1024 + h * 256;
#pragma unroll
    for (int j = 0; j < 4; ++j) {
        const int t = wr * 64 + j * 16 + fr;
        const float rs = rsqrtf(((SS[t] + SS[128 + t]) + (SS[256 + t] + SS[384 + t])) * (1.f / 256.f) + 1e-6f);
#pragma unroll
        for (int i = 0; i < 4; ++i) { const int dv = wc * 64 + i * 16 + 4 * fq;
            const f32x4 g = *(const f32x4*)(p.ml_norm_g + h * 256 + dv);
            const u32x2 oz = *(const u32x2*)(OZh + (size_t)t * 256 + dv);
            const f32x4 hv = acc[0][i][j];
            const float y0 = hv[0] * rs * g[0] * __uint_as_float(oz.x << 16), y1 = hv[1] * rs * g[1] * __uint_as_float(oz.x & 0xffff0000u);
            const float y2 = hv[2] * rs * g[2] * __uint_as_float(oz.y << 16), y3 = hv[3] * rs * g[3] * __uint_as_float(oz.y & 0xffff0000u);
            u32x2 pk; pk.x = pg8::cvt_pk_bf16(y0, y1); pk.y = pg8::cvt_pk_bf16(y2, y3);
            *(u32x2*)(YA + (size_t)t * 1024 + dv) = pk; }
        asm volatile("" ::: "memory");
    }
    (void)ssq;
}
__device__ __forceinline__ void phase_mout(const Params& p, LAS unsigned char* lds, int grp) {
    for (int it = blockIdx.x; it < NG * 4 * NCH; it += gridDim.x) mout_item(p, lds, grp, it >> 8, (it >> 6) & 3, it & 63);
}
}

__device__ __forceinline__ void phase_mix1(const Params& p, LAS unsigned char* lds, int grp) {
    pg8::Gemm g{(const bf16_t*)(p.ws + WS_YA), (const bf16_t*)(p.ws + WS_WA), TG, DM, DM};
    pg8::StaticOrder S; S.init(TG, DM, gridDim.x, (int)blockIdx.x);
    pg8::EpiMix<false> E{(const bf16_t*)(p.ws + WS_SGA), (bf16_t*)(p.ws + WS_MIX)};
    pg8::gemm_phase<pg8::EpiMix<false>, pg8::StaticOrder, true, true>(lds, g, S, E);
}
__device__ __forceinline__ void phase_mix2(const Params& p, LAS unsigned char* lds, int grp) {
    pg8::Gemm g{(const bf16_t*)(p.ws + WS_YB), (const bf16_t*)(p.ws + WS_WB), TG, DM, DM};
    pg8::StaticOrder S; S.init(TG, DM, gridDim.x, (int)blockIdx.x);
    pg8::EpiMix<true> E{(const bf16_t*)(p.ws + WS_SGB), (bf16_t*)(p.ws + WS_MIX)};
    pg8::gemm_phase<pg8::EpiMix<true>, pg8::StaticOrder, true, true>(lds, g, S, E);
}
__device__ __forceinline__ void phase_outproj(const Params& p, LAS unsigned char* lds, int grp) {
    pg8::Gemm g{(const bf16_t*)(p.ws + WS_MIX), (const bf16_t*)(p.ws + WS_WO), TG, DM, DM};
    pg8::StaticOrder S; S.init(TG, DM, gridDim.x, (int)blockIdx.x);
    pg8::EpiResid E{p.x + (size_t)grp * TG * DM, p.out + (size_t)grp * TG * DM};
    pg8::gemm_phase<pg8::EpiResid, pg8::StaticOrder, true, true>(lds, g, S, E);
}
__device__ __forceinline__ void phase_finalnorm(const Params& p, int grp) {
    const int tid = opaque_tid(), lane = tid & 63, wave = tid >> 6;
    const int gw = blockIdx.x * NWAVES + wave, NGW = gridDim.x * NWAVES;
    f32x4 vn[4];
    if (gw < TG) { const f32x4* xr0 = (const f32x4*)(p.out + ((size_t)grp * TG + gw) * DM) + lane;
#pragma unroll
        for (int j = 0; j < 4; ++j) vn[j] = xr0[64 * j]; }
    for (int m = gw; m < TG; m += NGW) {
        f32x4* xr = (f32x4*)(p.out + ((size_t)grp * TG + m) * DM) + lane;
        f32x4 v[4]; float s = 0.f;
#pragma unroll
        for (int j = 0; j < 4; ++j) { v[j] = vn[j]; s += (v[j][0] * v[j][0] + v[j][1] * v[j][1]) + (v[j][2] * v[j][2] + v[j][3] * v[j][3]); }
        if (m + NGW < TG) { const f32x4* xn = (const f32x4*)(p.out + ((size_t)grp * TG + m + NGW) * DM) + lane;
#pragma unroll
            for (int j = 0; j < 4; ++j) vn[j] = xn[64 * j]; }
        const float rstd = rsqrtf(wave_sum(s, lane) * (1.f / DM) + 1e-6f);
#pragma unroll
        for (int j = 0; j < 4; ++j) { const f32x4 g = *((const f32x4*)p.final_g + lane + 64 * j); xr[64 * j] = v[j] * rstd * g; }
    }
}
#define RLX_AGENT __ATOMIC_RELAXED, __HIP_MEMORY_SCOPE_AGENT
#define XB_TMO      128
#define XB_XCNT(j)  (256  + 64 * (j))
#define XB_XSUB(j)  (1280 + 64 * (j))
#define XB_XGEN(j)  (2304 + 64 * (j))
#define XB_TOP      3328
#define XB_TOPGEN   3392
#define XCD_BAR_WORDS 3456
#define XB_SPIN_CAP (1u << 18)

__device__ __forceinline__ unsigned xb_ld(unsigned* p)              { return __hip_atomic_load(p, __ATOMIC_RELAXED, __HIP_MEMORY_SCOPE_AGENT); }
__device__ __forceinline__ unsigned xb_add(unsigned* p, unsigned v) { return __hip_atomic_fetch_add(p, v, __ATOMIC_RELAXED, __HIP_MEMORY_SCOPE_AGENT); }
__device__ __forceinline__ unsigned xb_xcc_id() { return (unsigned)__builtin_amdgcn_s_getreg((3 << 11) | 20) & 0xFu; }
#define XB_SPIN(cond, bar) do { unsigned _sp = 0; while (cond) { __builtin_amdgcn_s_sleep(1); \
    if ((++_sp & 255u) == 0u) { if (xb_ld(&(bar)[XB_TMO])) break; if (_sp > XB_SPIN_CAP) { atomicAdd(&(bar)[XB_TMO], 1u); break; } } } } while (0)

struct XcdBarrier {
    unsigned* bar; unsigned x;
    volatile LAS unsigned* st;
};

__device__ __forceinline__ XcdBarrier xcd_barrier_post(unsigned* bar, volatile LAS unsigned* st) {
    XcdBarrier b; b.bar = bar; b.x = xb_xcc_id(); b.st = st;
    if (threadIdx.x == 0) (void)xb_add(&bar[XB_XCNT(b.x)], 1u);
    return b;
}
__device__ __forceinline__ void xcd_barrier_complete(unsigned* bar, unsigned x, unsigned& nloc, unsigned& nx) {
    const unsigned G = gridDim.x * gridDim.y * gridDim.z;
    unsigned sum, cnt, mine, sp = 0u;
    for (;;) {
        sum = 0u; cnt = 0u; mine = 0u;
#pragma unroll
        for (unsigned j = 0; j < 16; ++j) { const unsigned c = xb_ld(&bar[XB_XCNT(j)]); sum += c; cnt += (c > 0u) ? 1u : 0u; mine = (j == x) ? c : mine; }
        if (sum == G) break;
        __builtin_amdgcn_s_sleep(1);
        if ((++sp & 255u) == 0u) { if (xb_ld(&bar[XB_TMO])) break; if (sp > XB_SPIN_CAP) { atomicAdd(&bar[XB_TMO], 1u); break; } }
    }
    nloc = mine > 0u ? mine : 1u; nx = cnt > 0u ? cnt : 1u;
}

__device__ __forceinline__ void xcd_barrier(const XcdBarrier& b) {
    asm volatile("s_waitcnt vmcnt(0)" ::: "memory");
    __syncthreads();
    if (threadIdx.x == 0) {
        unsigned* bar = b.bar;
        __builtin_amdgcn_s_waitcnt(0);
        unsigned nloc = b.st[0], nx = b.st[1];
        if (nloc == 0u) { xcd_barrier_complete(bar, b.x, nloc, nx); b.st[0] = nloc; b.st[1] = nx; }
        const unsigned old = xb_add(&bar[XB_XSUB(b.x)], 1u);
        const unsigned gen = old / nloc;
        if (old + 1u == (gen + 1u) * nloc) {
            __builtin_amdgcn_fence(__ATOMIC_RELEASE, "agent");
            asm volatile("s_waitcnt vmcnt(0)" ::: "memory");
            const unsigned og = xb_add(&bar[XB_TOP], 1u);
            const unsigned tg = og / nx;
            if (og + 1u == (tg + 1u) * nx) xb_add(&bar[XB_TOPGEN], 1u);
            else XB_SPIN(xb_ld(&bar[XB_TOPGEN]) == tg, bar);
            __builtin_amdgcn_fence(__ATOMIC_ACQUIRE, "agent");
            xb_add(&bar[XB_XGEN(b.x)], 1u);
            asm volatile("s_waitcnt vmcnt(0)" ::: "memory");
        } else {
            XB_SPIN(xb_ld(&bar[XB_XGEN(b.x)]) == gen, bar);
            __builtin_amdgcn_fence(__ATOMIC_ACQUIRE, "agent");
            asm volatile("s_waitcnt vmcnt(0)" ::: "memory");
        }
    }
    __syncthreads();
}

constexpr int MISC_OFF = LDS_BYTES - 64;
__global__ void __launch_bounds__(NTHR, 2) mega_k(Params p) {
    extern __shared__ __attribute__((aligned(16))) unsigned char lds[];
    cg::grid_group grid = cg::this_grid();
    LAS unsigned char* L = (LAS unsigned char*)lds;
    volatile LAS unsigned* MISC = (volatile LAS unsigned*)(L + MISC_OFF);
    if (threadIdx.x < 16) MISC[threadIdx.x] = 0u;
    __syncthreads();
    XcdBarrier bar = xcd_barrier_post((unsigned*)(p.ws + WS_CTL) + 4096, MISC + 8);
    phase_prologue(p, L);
    grid.sync();
    for (int g = 0; g < NGRP; ++g) {
        ml::phase_gateprep(p, g);
        phase_inproj(p, L, g);
        xcd_barrier(bar);
        ml::phase_gatescan(p, L, g);
        phase_attention(p, (char*)lds, g);
        __syncthreads();
        ml::phase_mlocal(p, L, g);
        xcd_barrier(bar);
        ml::phase_mscan(p, g);
        xcd_barrier(bar);
        ml::phase_mout(p, L, g);
        xcd_barrier(bar);
        phase_mix1(p, L, g);
        __syncthreads();
        phase_mix2(p, L, g);
        xcd_barrier(bar);
        phase_outproj(p, L, g);
        xcd_barrier(bar);
        phase_finalnorm(p, g);
    }
}

extern "C" void kernel_launch(void* const* d_in, const int* in_sizes, int n_in, void* d_out, int out_size, void* d_ws, size_t ws_size, hipStream_t stream) {
    static int grid_blocks = 0;
    if (ws_size < WS_STF + GB || n_in != 14) { fprintf(stderr, "kernel_launch: needs 14 inputs and >= %zu bytes of workspace (got %d, %zu); nothing launched\n", (size_t)(WS_STF + GB), n_in, ws_size); return; }
    if (!grid_blocks) {
        int dev = 0, cus = 0, per_cu = 0;
        (void)hipGetDevice(&dev);
        (void)hipDeviceGetAttribute(&cus, hipDeviceAttributeMultiprocessorCount, dev);
        (void)hipFuncSetAttribute((const void*)mega_k, hipFuncAttributeMaxDynamicSharedMemorySize, LDS_BYTES);
        (void)hipOccupancyMaxActiveBlocksPerMultiprocessor(&per_cu, (const void*)mega_k, NTHR, LDS_BYTES);
        if (per_cu < 1) per_cu = 1;
        grid_blocks = cus * per_cu;
        if (grid_blocks > 256) grid_blocks = 256;
    }
    Params p{};
    p.x = (const float*)d_in[0]; p.pos = (const int*)d_in[1]; p.norm_g = (const float*)d_in[2]; p.w_in = (const float*)d_in[3];
    p.ml_gate_b = (const float*)d_in[4]; p.ml_conv_w = (const float*)d_in[5]; p.ml_norm_g = (const float*)d_in[6]; p.da_lambda = (const float*)d_in[7];
    p.da_subln_g = (const float*)d_in[8]; p.gate_b = (const float*)d_in[9]; p.w_a = (const float*)d_in[10]; p.w_b = (const float*)d_in[11];
    p.w_out = (const float*)d_in[12]; p.final_g = (const float*)d_in[13];
    p.out = (float*)d_out; p.ws = (unsigned char*)d_ws; p.grp = 0; p.pad = 0;
    (void)hipMemsetAsync((char*)d_ws + WS_CTL, 0, 65536, stream);
    void* args[] = {&p};
    hipError_t e = hipLaunchCooperativeKernel((const void*)mega_k, dim3(grid_blocks), dim3(NTHR), args, LDS_BYTES, stream);
    if (e != hipSuccess) fprintf(stderr, "cooperative launch failed: %s (grid %d)\n", hipGetErrorString(e), grid_blocks);
}
```
